# Optimizing an MI355X kernel written in HIP

```python
import math
import jax, jax.numpy as jnp
from jax import lax
import numpy as np

D_MODEL = 1024
BATCH = 4
SEQ = 8192
DEPTH = 4

HEAD_DIM = 64
N_HEADS = 8
N_KV_HEADS = 2
GQA_GROUP = N_HEADS // N_KV_HEADS
ATTN_WIDTH = N_HEADS * HEAD_DIM
KV_WIDTH = N_KV_HEADS * HEAD_DIM
CONV_WIDTH = D_MODEL - ATTN_WIDTH
MIX_WIDTH = ATTN_WIDTH + CONV_WIDTH
IN_WIDTH = ATTN_WIDTH + 2 * KV_WIDTH + 2 * CONV_WIDTH
WINDOW = 128
BLOCK = 128
CONV_KERNEL = 31
NUM_BUCKETS = 32
MAX_DISTANCE = 128
D_FF = 4 * D_MODEL
EPS = 1e-6
NEG = -1e30

kernel_name = "hymba_conformer_swa_sink_hybrid"


def rms_norm(x, g):
    xf = x.astype(jnp.float32)
    y = xf * lax.rsqrt(jnp.mean(xf * xf, axis=-1, keepdims=True) + EPS)
    return (y * g.astype(jnp.float32)).astype(x.dtype)


def layer_norm(x, g, b):
    xf = x.astype(jnp.float32)
    mu = jnp.mean(xf, axis=-1, keepdims=True)
    var = jnp.mean(jnp.square(xf - mu), axis=-1, keepdims=True)
    y = (xf - mu) * lax.rsqrt(var + EPS)
    return (y * g.astype(jnp.float32) + b.astype(jnp.float32)).astype(x.dtype)


def t5_causal_bucket(n):
    n = np.asarray(n)
    max_exact = NUM_BUCKETS // 2
    large = max_exact + (np.log(np.maximum(n, 1) / max_exact)
                         / np.log(MAX_DISTANCE / max_exact)
                         * (NUM_BUCKETS - max_exact)).astype(np.int32)
    large = np.minimum(large, NUM_BUCKETS - 1)
    return np.where(n < max_exact, n, large).astype(np.int32)


def band_structure(seq_len):
    n_blocks = seq_len // BLOCK
    qi = np.arange(BLOCK)[:, None]
    kj = np.arange(2 * BLOCK)[None, :]
    dist = qi + BLOCK - kj
    in_window = (dist >= 0) & (dist < WINDOW)
    bucket = t5_causal_bucket(np.clip(dist, 0, None))
    k_abs = (np.arange(n_blocks)[:, None] - 1) * BLOCK + np.arange(2 * BLOCK)[None, :]
    valid = in_window[None, :, :] & (k_abs >= 0)[:, None, :]
    return bucket, valid


def sliding_window_gqa(q, k, v, sinks, rel_bias):
    B, T = q.shape[0], q.shape[1]
    nb = T // BLOCK
    bucket, valid = band_structure(T)
    bias = jnp.transpose(rel_bias[bucket].astype(jnp.float32), (2, 0, 1))
    bias = bias.reshape(N_KV_HEADS, GQA_GROUP, BLOCK, 2 * BLOCK)

    qb = q.reshape(B, nb, BLOCK, N_KV_HEADS, GQA_GROUP, HEAD_DIM)

    def band(t):
        tp = jnp.pad(t, ((0, 0), (BLOCK, 0), (0, 0), (0, 0)))
        prev = tp[:, :T].reshape(B, nb, BLOCK, N_KV_HEADS, HEAD_DIM)
        cur = t.reshape(B, nb, BLOCK, N_KV_HEADS, HEAD_DIM)
        return jnp.concatenate([prev, cur], axis=2)

    kb, vb = band(k), band(v)
    scale = 1.0 / math.sqrt(HEAD_DIM)
    s = jnp.einsum('bnqkgd,bnskd->bnkgqs', qb, kb).astype(jnp.float32) * scale
    s = s + bias[None, None]
    s = jnp.where(jnp.asarray(valid)[None, :, None, None, :, :], s, NEG)
    sink = sinks.astype(jnp.float32).reshape(N_KV_HEADS, GQA_GROUP)[None, None, :, :, None, None]
    m = jnp.maximum(jnp.max(s, axis=-1, keepdims=True), sink)
    p = jnp.exp(s - m)
    p = p / (jnp.sum(p, axis=-1, keepdims=True) + jnp.exp(sink - m))
    o = jnp.einsum('bnkgqs,bnskd->bnqkgd', p.astype(v.dtype), vb)
    return o.reshape(B, T, ATTN_WIDTH)


def conformer_conv(u, gate, conv_w, conv_b, ln_g, ln_b):
    h = u * jax.nn.sigmoid(gate)
    hp = jnp.pad(h, ((0, 0), (CONV_KERNEL - 1, 0), (0, 0)))
    y = lax.conv_general_dilated(
        hp, conv_w[:, None, :].astype(h.dtype), window_strides=(1,), padding='VALID',
        dimension_numbers=('NWC', 'WIO', 'NWC'), feature_group_count=CONV_WIDTH)
    y = y + conv_b
    y = layer_norm(y, ln_g, ln_b)
    return jax.nn.silu(y)


def setup_inputs(seed: int = 0) -> dict:
    key = jax.random.key(seed)
    ks = jax.random.split(key, 20)
    f32 = jnp.float32
    nrm = lambda k, shape, s: (jax.random.normal(k, shape, f32) * s).astype(f32)
    return {
        "x": nrm(ks[0], (BATCH, SEQ, D_MODEL), 1.0),
        "rel_bias": nrm(ks[1], (NUM_BUCKETS, N_HEADS), 0.5),
        "norm_mix_g": 1.0 + nrm(ks[2], (DEPTH, D_MODEL), 0.02),
        "w_in": nrm(ks[3], (DEPTH, D_MODEL, IN_WIDTH), D_MODEL ** -0.5),
        "q_norm_g": 1.0 + nrm(ks[4], (DEPTH, HEAD_DIM), 0.02),
        "k_norm_g": 1.0 + nrm(ks[5], (DEPTH, HEAD_DIM), 0.02),
        "sinks": nrm(ks[6], (DEPTH, N_HEADS), 0.5),
        "conv_w": nrm(ks[7], (DEPTH, CONV_KERNEL, CONV_WIDTH), CONV_KERNEL ** -0.5),
        "conv_b": nrm(ks[8], (DEPTH, CONV_WIDTH), 0.02),
        "conv_ln_g": 1.0 + nrm(ks[9], (DEPTH, CONV_WIDTH), 0.02),
        "conv_ln_b": nrm(ks[10], (DEPTH, CONV_WIDTH), 0.02),
        "attn_out_g": 1.0 + nrm(ks[11], (DEPTH, ATTN_WIDTH), 0.02),
        "conv_out_g": 1.0 + nrm(ks[12], (DEPTH, CONV_WIDTH), 0.02),
        "w_out": nrm(ks[13], (DEPTH, MIX_WIDTH, D_MODEL), (MIX_WIDTH * 2 * DEPTH) ** -0.5),
        "norm_mlp_g": 1.0 + nrm(ks[14], (DEPTH, D_MODEL), 0.02),
        "w_mlp_up": nrm(ks[15], (DEPTH, D_MODEL, D_FF), D_MODEL ** -0.5),
        "w_mlp_down": nrm(ks[16], (DEPTH, D_FF, D_MODEL), (D_FF * 2 * DEPTH) ** -0.5),
    }


def reference(x, rel_bias, norm_mix_g, w_in, q_norm_g, k_norm_g, sinks, conv_w, conv_b,
              conv_ln_g, conv_ln_b, attn_out_g, conv_out_g, w_out, norm_mlp_g,
              w_mlp_up, w_mlp_down):
    B, T, _ = x.shape
    splits = [ATTN_WIDTH, ATTN_WIDTH + KV_WIDTH, ATTN_WIDTH + 2 * KV_WIDTH,
              ATTN_WIDTH + 2 * KV_WIDTH + CONV_WIDTH]
    for l in range(DEPTH):
        h = rms_norm(x, norm_mix_g[l])
        z = h @ w_in[l]
        q, k, v, u, gate = jnp.split(z, splits, axis=-1)
        q = rms_norm(q.reshape(B, T, N_HEADS, HEAD_DIM), q_norm_g[l])
        k = rms_norm(k.reshape(B, T, N_KV_HEADS, HEAD_DIM), k_norm_g[l])
        v = v.reshape(B, T, N_KV_HEADS, HEAD_DIM)
        a = sliding_window_gqa(q, k, v, sinks[l], rel_bias)
        c = conformer_conv(u, gate, conv_w[l], conv_b[l], conv_ln_g[l], conv_ln_b[l])
        mix = jnp.concatenate([rms_norm(a, attn_out_g[l]), rms_norm(c, conv_out_g[l])], axis=-1)
        x = x + mix @ w_out[l]
        h = rms_norm(x, norm_mlp_g[l])
        x = x + jnp.square(jax.nn.relu(h @ w_mlp_up[l])) @ w_mlp_down[l]
    return x
```

```cpp
#define RES_BF16 0
#include <hip/hip_runtime.h>
#include <hip/hip_cooperative_groups.h>
#include <cstdio>
#include <cstdint>
#include <utility>
namespace cg = cooperative_groups;
namespace pg8 {
#define PG8_LAS __attribute__((address_space(3)))
typedef unsigned short bf16_t;
typedef short bf16x8 __attribute__((ext_vector_type(8)));
typedef float f32x4 __attribute__((ext_vector_type(4)));
typedef unsigned u32x4 __attribute__((ext_vector_type(4)));
constexpr int BM = 256, BK = 64, HALF = 128, HTB = HALF * BK * 2  , STAGE_BYTES = 8 * HTB, NXCD = 8, WGM = 8;

__host__ __device__ __forceinline__ int lds_byte(int r, int c) { const int st = (r >> 4) * 2 + (c >> 5), rr = r & 15, cc = c & 31, ob = rr * 64 + cc * 2; return st * 1024 + (ob ^ (((ob >> 9) & 1) << 5)); }
__host__ __device__ __forceinline__ void stage_rc(int b, int& R, int& C) { const int st = b / 1024, sb = b % 1024, swz = sb ^ (((sb >> 9) & 1) << 5); R = (st >> 1) * 16 + swz / 64; C = (st & 1) * 32 + (swz % 64) / 2; }
__host__ __device__ __forceinline__ int perm32(int rho) { const int n = rho >> 4, i = rho & 15; return 8 * (i >> 2) + 4 * n + (i & 3); }

struct Unit { int pm, pn; };
struct Gemm { const bf16_t* A; const bf16_t* Bt; int M, N, K; };

struct StaticOrder {
    int nM, nN, nwg, G, c;
    __host__ __device__ void init(int M, int N, int G_, int c_) { nM = M / BM; nN = N / BM; nwg = nM * nN; G = G_; c = c_; }
    __host__ __device__ bool next(int i, Unit& u) const {
        const long L = (long)i * G + c; if (L >= nwg) return false;
        int wgid = (int)L; { const int q = nwg / NXCD, r = nwg % NXCD, xcd = wgid % NXCD, off = wgid / NXCD; wgid = (xcd < r ? xcd * (q + 1) : r * (q + 1) + (xcd - r) * q) + off; }
        const int nig = WGM * nN, gid = wgid / nig, fm = gid * WGM, gsz = (nM - fm) < WGM ? (nM - fm) : WGM;
        u.pm = fm + ((wgid % nig) % gsz); u.pn = (wgid % nig) / gsz; return true;
    }
    __device__ __forceinline__ void a_ready(const Unit&) const {}
    __device__ __forceinline__ void done(const Unit&) const {}
};

__device__ __forceinline__ unsigned cvt_pk_bf16(float lo, float hi) { unsigned r; asm volatile("v_cvt_pk_bf16_f32 %0, %1, %2" : "=v"(r) : "v"(lo), "v"(hi)); return r; }
typedef float f32x2 __attribute__((ext_vector_type(2)));
constexpr float EPS_ = 1e-6f;
constexpr int TT = 8192;
constexpr float QSCALE = 0.125f * 1.4426950408889634f;
__device__ __forceinline__ float xsum4(float s) {
    const auto a = __builtin_amdgcn_permlane16_swap(__float_as_uint(s), __float_as_uint(s), false, false); s = __uint_as_float(a[0]) + __uint_as_float(a[1]);
    const auto b = __builtin_amdgcn_permlane32_swap(__float_as_uint(s), __float_as_uint(s), false, false); return __uint_as_float(b[0]) + __uint_as_float(b[1]);
}
__device__ __forceinline__ float row_rstd(const float* ssq, int row, int fq) {
    const f32x4 p = *(const f32x4*)(ssq + (size_t)row * 16 + fq * 4);
    float s = (p[0] + p[1]) + (p[2] + p[3]); s = xsum4(s);
    return rsqrtf(s * (1.0f / 1024.0f) + EPS_);
}
__device__ __forceinline__ u32x4 pack8(const f32x4 a, const f32x4 b) { u32x4 w; w.x = cvt_pk_bf16(a[0], a[1]); w.y = cvt_pk_bf16(a[2], a[3]); w.z = cvt_pk_bf16(b[0], b[1]); w.w = cvt_pk_bf16(b[2], b[3]); return w; }

__device__ __forceinline__ void zero_acc(f32x4 (&acc)[2][2][4][2]) {
#pragma unroll
    for (int a = 0; a < 2; ++a)
#pragma unroll
        for (int b = 0; b < 2; ++b)
#pragma unroll
            for (int m = 0; m < 4; ++m)
#pragma unroll
                for (int n = 0; n < 2; ++n) acc[a][b][m][n] = (f32x4){0.f, 0.f, 0.f, 0.f};
}
struct EpiIn {
    static constexpr bool PERM = true, AFTER_DRAIN = false;
    const float* ssq; const float* qg; const float* kg;
    bf16_t* Q; bf16_t* Kb; bf16_t* Vg; bf16_t* Hg;
    __device__ __forceinline__ void init(f32x4 (&acc)[2][2][4][2], const Unit&, int, int, int, int) const { zero_acc(acc); }
    __device__ __forceinline__ void operator()(const f32x4 (&acc)[2][2][4][2], const Unit& u, int wr, int wc, int fr, int fq) const {
        const int pn = u.pn;
        float rsv[2][4];
        { f32x4 pv[2][4];
#pragma unroll
          for (int ai = 0; ai < 2; ++ai)
#pragma unroll
              for (int m = 0; m < 4; ++m) pv[ai][m] = *(const f32x4*)(ssq + (size_t)(u.pm * BM + ai * HALF + wr * 64 + m * 16 + fr) * 16 + fq * 4);
          __builtin_amdgcn_sched_barrier(0);
#pragma unroll
          for (int ai = 0; ai < 2; ++ai)
#pragma unroll
              for (int m = 0; m < 4; ++m) { const f32x4 p = pv[ai][m]; rsv[ai][m] = rsqrtf(xsum4((p[0] + p[1]) + (p[2] + p[3])) * (1.0f / 1024.0f) + EPS_); } }
        if (pn >= 3) {
#pragma unroll
            for (int ai = 0; ai < 2; ++ai)
#pragma unroll
                for (int m = 0; m < 4; ++m) {
                    const int row = u.pm * BM + ai * HALF + wr * 64 + m * 16 + fr; const float rs = rsv[ai][m];
                    f32x4 h[2];
#pragma unroll
                    for (int n = 0; n < 2; ++n)
#pragma unroll
                        for (int i = 0; i < 4; ++i) { const float uu = acc[ai][0][m][n][i] * rs, gg = acc[ai][1][m][n][i] * rs; h[n][i] = uu * __builtin_amdgcn_rcpf(1.0f + __expf(-gg)); }
                    *(u32x4*)(Hg + (size_t)row * 512 + (pn - 3) * 128 + wc * 32 + fq * 8) = pack8(h[0], h[1]);
                }
        } else if (pn < 2 || wc < 2) {
            const bool isq = pn < 2; const float* g = isq ? qg : kg; const float osc = isq ? QSCALE : 1.0f;
            bf16_t* base = isq ? Q + (pn * 4 + wc) * 64 : Kb + wc * 64; const int ld = isq ? 512 : 128;
            f32x4 gv[2][2];
#pragma unroll
            for (int bj = 0; bj < 2; ++bj)
#pragma unroll
                for (int n = 0; n < 2; ++n) gv[bj][n] = *(const f32x4*)(g + bj * 32 + fq * 8 + n * 4);
#pragma unroll
            for (int ai = 0; ai < 2; ++ai)
#pragma unroll
                for (int m = 0; m < 4; ++m) {
                    const int row = u.pm * BM + ai * HALF + wr * 64 + m * 16 + fr; const float rs = rsv[ai][m];
                    f32x4 v[2][2]; float ss = 0.f;
#pragma unroll
                    for (int bj = 0; bj < 2; ++bj)
#pragma unroll
                        for (int n = 0; n < 2; ++n) { v[bj][n] = acc[ai][bj][m][n] * rs; const f32x4 q = v[bj][n] * v[bj][n]; ss += (q[0] + q[1]) + (q[2] + q[3]); }
                    ss = xsum4(ss); const float r = rsqrtf(ss * (1.0f / 64.0f) + EPS_) * osc;
#pragma unroll
                    for (int bj = 0; bj < 2; ++bj) *(u32x4*)(base + (size_t)row * ld + bj * 32 + fq * 8) = pack8(v[bj][0] * gv[bj][0] * r, v[bj][1] * gv[bj][1] * r);
                }
        } else {
            const int kvh = wc - 2;
#pragma unroll
            for (int ai = 0; ai < 2; ++ai)
#pragma unroll
                for (int m = 0; m < 4; ++m) {
                    const int row = u.pm * BM + ai * HALF + wr * 64 + m * 16 + fr; const float rs = rsv[ai][m];
                    const int b = row / TT, t = row % TT;
#pragma unroll
                    for (int bj = 0; bj < 2; ++bj) { const int dc = bj * 4 + fq;
                        *(u32x4*)(Vg + ((size_t)((b * 2 + kvh) * 8 + dc) * TT + t) * 8) = pack8(acc[ai][bj][m][0] * rs, acc[ai][bj][m][1] * rs); }
                }
        }
    }
};
#ifndef RES_BF16
#define RES_BF16 1
#endif
struct EpiRes {
    static constexpr bool PERM = true, AFTER_DRAIN = false;
    const float* resid; float* xout; bf16_t* xb; float* ssq;
    __device__ __forceinline__ void init(f32x4 (&acc)[2][2][4][2], const Unit& u, int wr, int wc, int fr, int fq) const {
        if (resid) {
#pragma unroll
            for (int ai = 0; ai < 2; ++ai)
#pragma unroll
                for (int m = 0; m < 4; ++m) { const int row = u.pm * BM + ai * HALF + wr * 64 + m * 16 + fr;
#pragma unroll
                    for (int bj = 0; bj < 2; ++bj) { const size_t off = (size_t)row * 1024 + u.pn * BM + bj * HALF + wc * 32 + fq * 8;
                        acc[ai][bj][m][0] = *(const f32x4*)(resid + off); acc[ai][bj][m][1] = *(const f32x4*)(resid + off + 4); } }
        } else {
            u32x4 w[2][4][2];
#pragma unroll
            for (int ai = 0; ai < 2; ++ai)
#pragma unroll
                for (int m = 0; m < 4; ++m) { const int row = u.pm * BM + ai * HALF + wr * 64 + m * 16 + fr;
#pragma unroll
                    for (int bj = 0; bj < 2; ++bj) w[ai][m][bj] = *(const u32x4*)(xb + (size_t)row * 1024 + u.pn * BM + bj * HALF + wc * 32 + fq * 8); }
            __builtin_amdgcn_sched_barrier(0);
#pragma unroll
            for (int ai = 0; ai < 2; ++ai)
#pragma unroll
                for (int m = 0; m < 4; ++m)
#pragma unroll
                    for (int bj = 0; bj < 2; ++bj) { const u32x4 x = w[ai][m][bj];
                        acc[ai][bj][m][0] = (f32x4){__uint_as_float(x.x << 16), __uint_as_float(x.x & 0xffff0000u), __uint_as_float(x.y << 16), __uint_as_float(x.y & 0xffff0000u)};
                        acc[ai][bj][m][1] = (f32x4){__uint_as_float(x.z << 16), __uint_as_float(x.z & 0xffff0000u), __uint_as_float(x.w << 16), __uint_as_float(x.w & 0xffff0000u)}; }
        }
    }
    __device__ __forceinline__ void operator()(const f32x4 (&acc)[2][2][4][2], const Unit& u, int wr, int wc, int fr, int fq) const {
#pragma unroll
        for (int ai = 0; ai < 2; ++ai)
#pragma unroll
            for (int m = 0; m < 4; ++m) {
                const int row = u.pm * BM + ai * HALF + wr * 64 + m * 16 + fr; float ss = 0.f;
#pragma unroll
                for (int bj = 0; bj < 2; ++bj) { const size_t off = (size_t)row * 1024 + u.pn * BM + bj * HALF + wc * 32 + fq * 8;
                    const f32x4 v0 = acc[ai][bj][m][0], v1 = acc[ai][bj][m][1];
                    if (xout) { __builtin_nontemporal_store(v0, (f32x4*)(xout + off)); __builtin_nontemporal_store(v1, (f32x4*)(xout + off + 4)); }
                    *(u32x4*)(xb + off) = pack8(v0, v1);
                    const f32x4 q0 = v0 * v0, q1 = v1 * v1; ss += ((q0[0] + q0[1]) + (q0[2] + q0[3])) + ((q1[0] + q1[1]) + (q1[2] + q1[3])); }
                ss = xsum4(ss);
                if (fq == 0) ssq[(size_t)row * 16 + u.pn * 4 + wc] = ss;
            }
    }
};
struct EpiUp {
    static constexpr bool PERM = true, AFTER_DRAIN = false;
    const float* ssq; bf16_t* Hid;
    __device__ __forceinline__ void init(f32x4 (&acc)[2][2][4][2], const Unit&, int, int, int, int) const { zero_acc(acc); }
    __device__ __forceinline__ void operator()(const f32x4 (&acc)[2][2][4][2], const Unit& u, int wr, int wc, int fr, int fq) const {
        float rsv[2][4];
        { f32x4 pv[2][4];
#pragma unroll
          for (int ai = 0; ai < 2; ++ai)
#pragma unroll
              for (int m = 0; m < 4; ++m) pv[ai][m] = *(const f32x4*)(ssq + (size_t)(u.pm * BM + ai * HALF + wr * 64 + m * 16 + fr) * 16 + fq * 4);
          __builtin_amdgcn_sched_barrier(0);
#pragma unroll
          for (int ai = 0; ai < 2; ++ai)
#pragma unroll
              for (int m = 0; m < 4; ++m) { const f32x4 p = pv[ai][m]; rsv[ai][m] = rsqrtf(xsum4((p[0] + p[1]) + (p[2] + p[3])) * (1.0f / 1024.0f) + EPS_); } }
#pragma unroll
        for (int ai = 0; ai < 2; ++ai)
#pragma unroll
            for (int m = 0; m < 4; ++m) {
                const int row = u.pm * BM + ai * HALF + wr * 64 + m * 16 + fr; const float rs = rsv[ai][m];
#pragma unroll
                for (int bj = 0; bj < 2; ++bj) { f32x4 v0 = acc[ai][bj][m][0] * rs, v1 = acc[ai][bj][m][1] * rs;
#pragma unroll
                    for (int i = 0; i < 4; ++i) { const float a = fmaxf(v0[i], 0.f), b = fmaxf(v1[i], 0.f); v0[i] = a * a; v1[i] = b * b; }
                    *(u32x4*)(Hid + (size_t)row * 4096 + u.pn * BM + bj * HALF + wc * 32 + fq * 8) = pack8(v0, v1); }

            }
    }
};
template <class Epi, class Sched, bool ALIGN_EPI = false, bool SP2 = false, bool ZZ = false>
__device__ __forceinline__ void gemm_phase(PG8_LAS unsigned char* lds, const Gemm g, const Sched& S, const Epi& E) {
    int tid_ = threadIdx.x; asm volatile("" : "+v"(tid_));
    const int tid = tid_, wid = __builtin_amdgcn_readfirstlane(tid >> 6), lane = tid & 63, wr = wid >> 2, wc = wid & 3, fr = lane & 15, fq = lane >> 4;
    const int K = g.K, nt = K / BK;
    unsigned voffA[2], voffB[2];
#pragma unroll
    for (int i = 0; i < 2; ++i) { int R, C; stage_rc(tid * 16 + i * 8192, R, C); const int Rb = Epi::PERM ? ((R & ~31) + perm32(R & 31)) : R;
        voffA[i] = (unsigned)(R * K + C) * 2u; voffB[i] = (unsigned)(Rb * K + C) * 2u; }
    const long kstep = (long)(BK * 2);
    const size_t hstep = (size_t)HALF * K * 2;
    const size_t tstep = 2 * hstep;
    const unsigned ldsw = (unsigned)wid * 1024u;
    const int aoff = lds_byte(wr * 64 + fr, fq * 8), boff = lds_byte(wc * 32 + fr, fq * 8);
#define PG8_SA(b, h) (((b) * 2 + (h)) * HTB)
#define PG8_SB(b, h) ((4 + (b) * 2 + (h)) * HTB)
#define PG8_STAGE(bufoff, gbase, voff) do { _Pragma("unroll") for (int _i = 0; _i < 2; ++_i) \
        __builtin_amdgcn_global_load_lds((const unsigned*)((const char*)(gbase) + (voff)[_i]), (PG8_LAS unsigned*)(lds + (bufoff) + ldsw + _i * 8192), 16, 0, 0); } while (0)
#define PG8_LDA(dst, b, h) do { _Pragma("unroll") for (int m = 0; m < 4; ++m) _Pragma("unroll") for (int k = 0; k < 2; ++k) dst[m][k] = *(const PG8_LAS bf16x8*)(lds + PG8_SA(b, h) + aoff + m * 2048 + k * 1024); } while (0)
#define PG8_LDB(dst, b, h) do { _Pragma("unroll") for (int n = 0; n < 2; ++n) _Pragma("unroll") for (int k = 0; k < 2; ++k) dst[n][k] = *(const PG8_LAS bf16x8*)(lds + PG8_SB(b, h) + boff + n * 2048 + k * 1024); } while (0)
#define PG8_MMA(ai, bj, At, Bt) do { __builtin_amdgcn_s_setprio(1); _Pragma("unroll") for (int m = 0; m < 4; ++m) _Pragma("unroll") for (int n = 0; n < 2; ++n) _Pragma("unroll") for (int k = 0; k < 2; ++k) \
        acc[ai][bj][m][n] = __builtin_amdgcn_mfma_f32_16x16x32_bf16(Bt[n][k], At[m][k], acc[ai][bj][m][n], 0, 0, 0); __builtin_amdgcn_s_setprio(0); } while (0)
#define PG8_WAIT_V(n) asm volatile("s_waitcnt vmcnt(" #n ")" ::: "memory")
#define PG8_WAIT_L(n) asm volatile("s_waitcnt lgkmcnt(" #n ")" ::: "memory")
#define PG8_BAR __builtin_amdgcn_s_barrier()
#define PG8_SCHED __builtin_amdgcn_sched_barrier(0)
    Unit cur, nxt; int ui = 0;
    if (!S.next(0, cur)) return;
    f32x4 acc[2][2][4][2];
    E.init(acc, cur, wr, wc, fr, fq);
    bf16x8 At[4][2], B0[2][2], B1[2][2];
    const char* cA = (const char*)g.A + (size_t)cur.pm * tstep; const char* cB = (const char*)g.Bt + (size_t)cur.pn * tstep;
    long ks = kstep, ksn = kstep;
    S.a_ready(cur);
    if constexpr (SP2) {
        PG8_STAGE(PG8_SB(0, 0), cB, voffB); PG8_STAGE(PG8_SB(0, 1), cB + hstep, voffB); PG8_STAGE(PG8_SA(0, 0), cA, voffA); PG8_STAGE(PG8_SA(0, 1), cA + hstep, voffA);
        if (wr == 1) PG8_BAR;
        PG8_WAIT_V(2); PG8_BAR;
        PG8_STAGE(PG8_SB(1, 0), cB + kstep, voffB); PG8_STAGE(PG8_SA(1, 0), cA + kstep, voffA); PG8_STAGE(PG8_SB(1, 1), cB + hstep + kstep, voffB);
        PG8_WAIT_V(6); PG8_BAR;
    } else {
        PG8_STAGE(PG8_SB(0, 0), cB, voffB); PG8_STAGE(PG8_SA(0, 0), cA, voffA); PG8_STAGE(PG8_SB(0, 1), cB + hstep, voffB); PG8_STAGE(PG8_SA(0, 1), cA + hstep, voffA);
        if (wr == 1) PG8_BAR;
        PG8_WAIT_V(4); PG8_BAR;
        PG8_STAGE(PG8_SB(1, 0), cB + kstep, voffB); PG8_STAGE(PG8_SA(1, 0), cA + kstep, voffA); PG8_STAGE(PG8_SB(1, 1), cB + hstep + kstep, voffB);
        PG8_WAIT_V(6); PG8_BAR;
    }
    for (;;) {
        const bool has_next = S.next(ui + 1, nxt);
        const bool nrev = ZZ && has_next && (((ui + 1) & 1) != 0); const long noff = nrev ? (long)(nt - 1) * kstep : 0l;
        ksn = has_next ? (nrev ? -kstep : kstep) : ks;
        const char* nA = has_next ? (const char*)g.A + (size_t)nxt.pm * tstep + noff : cA; const char* nB = has_next ? (const char*)g.Bt + (size_t)nxt.pn * tstep + noff : cB;
        for (int t = 0; t < nt; t += 2) {
            const bool last = (t == nt - 2);
            const char* a1 = cA + (long)(t + 1) * ks;
            const char* a2 = last ? nA : cA + (long)(t + 2) * ks; const char* b2 = last ? nB : cB + (long)(t + 2) * ks;
            const long k3 = last ? ksn : ks; const char* a3 = a2 + k3; const char* b3 = b2 + k3;
            if (last && has_next) S.a_ready(nxt);
            if constexpr (SP2) {
            PG8_LDB(B0, 0, 0); PG8_LDB(B1, 0, 1); PG8_SCHED; PG8_LDA(At, 0, 0); PG8_STAGE(PG8_SA(1, 1), a1 + hstep, voffA);
            PG8_WAIT_V(8); PG8_WAIT_L(0); PG8_BAR; PG8_MMA(0, 0, At, B0); PG8_MMA(0, 1, At, B1); PG8_BAR; PG8_SCHED;
            PG8_LDA(At, 0, 1); PG8_STAGE(PG8_SB(0, 0), b2, voffB); PG8_STAGE(PG8_SB(0, 1), b2 + hstep, voffB); PG8_STAGE(PG8_SA(0, 0), a2, voffA);
            PG8_WAIT_V(8); PG8_WAIT_L(0); PG8_BAR; PG8_MMA(1, 0, At, B0); PG8_MMA(1, 1, At, B1); PG8_BAR; PG8_SCHED;
            PG8_LDB(B0, 1, 0); PG8_LDB(B1, 1, 1); PG8_SCHED; PG8_LDA(At, 1, 0); PG8_STAGE(PG8_SA(0, 1), a2 + hstep, voffA);
            PG8_WAIT_V(8); PG8_WAIT_L(0); PG8_BAR; PG8_MMA(0, 0, At, B0); PG8_MMA(0, 1, At, B1); PG8_BAR; PG8_SCHED;
            PG8_LDA(At, 1, 1); PG8_STAGE(PG8_SB(1, 0), b3, voffB); PG8_STAGE(PG8_SB(1, 1), b3 + hstep, voffB); PG8_STAGE(PG8_SA(1, 0), a3, voffA);
            PG8_WAIT_V(8); PG8_WAIT_L(0); PG8_BAR; PG8_MMA(1, 0, At, B0); PG8_MMA(1, 1, At, B1); PG8_BAR; PG8_SCHED;
            } else {
            PG8_LDB(B0, 0, 0); PG8_SCHED; PG8_LDA(At, 0, 0); PG8_STAGE(PG8_SA(1, 1), a1 + hstep, voffA);
            PG8_WAIT_L(8); PG8_BAR; PG8_WAIT_L(0); PG8_MMA(0, 0, At, B0); PG8_BAR; PG8_SCHED;
            PG8_LDB(B1, 0, 1); PG8_STAGE(PG8_SB(0, 0), b2, voffB);
            PG8_BAR; PG8_WAIT_L(0); PG8_MMA(0, 1, At, B1); PG8_BAR;
            PG8_LDA(At, 0, 1); PG8_STAGE(PG8_SA(0, 0), a2, voffA);
            PG8_BAR; PG8_WAIT_L(0); PG8_MMA(1, 0, At, B0); PG8_BAR; PG8_SCHED;
            PG8_STAGE(PG8_SB(0, 1), b2 + hstep, voffB);
            PG8_WAIT_V(6); PG8_BAR; PG8_MMA(1, 1, At, B1); PG8_BAR;
            PG8_LDB(B0, 1, 0); PG8_SCHED; PG8_LDA(At, 1, 0); PG8_STAGE(PG8_SA(0, 1), a2 + hstep, voffA);
            PG8_WAIT_L(8); PG8_BAR; PG8_WAIT_L(0); PG8_MMA(0, 0, At, B0); PG8_BAR; PG8_SCHED;
            PG8_LDB(B1, 1, 1); PG8_STAGE(PG8_SB(1, 0), b3, voffB);
            PG8_BAR; PG8_WAIT_L(0); PG8_MMA(0, 1, At, B1); PG8_BAR;
            PG8_LDA(At, 1, 1); PG8_STAGE(PG8_SA(1, 0), a3, voffA);
            PG8_BAR; PG8_WAIT_L(0); PG8_MMA(1, 0, At, B0); PG8_BAR; PG8_SCHED;
            PG8_STAGE(PG8_SB(1, 1), b3 + hstep, voffB);
            PG8_WAIT_V(6); PG8_BAR; PG8_MMA(1, 1, At, B1); PG8_BAR;
            }
        }
        if constexpr (ALIGN_EPI) { if (wr == 0) PG8_BAR; }
        if constexpr (!Epi::AFTER_DRAIN) { E(acc, cur, wr, wc, fr, fq); S.done(cur); }
        if (!has_next) break;
        E.init(acc, nxt, wr, wc, fr, fq);
        cur = nxt; cA = nA; cB = nB; ks = ksn; ++ui;
        if constexpr (ALIGN_EPI) { if (wr == 1) PG8_BAR; }
    }
    PG8_WAIT_V(0);
    if constexpr (!ALIGN_EPI) { if (wr == 0) PG8_BAR; }
    PG8_BAR;
    if constexpr (Epi::AFTER_DRAIN) { E.fused(acc, cur, wr, wc, fr, fq, lds, wid, lane); S.done(cur); }
#undef PG8_SA
#undef PG8_SB
#undef PG8_STAGE
#undef PG8_LDA
#undef PG8_LDB
#undef PG8_MMA
#undef PG8_WAIT_V
#undef PG8_WAIT_L
#undef PG8_BAR
#undef PG8_SCHED
}
}
#define LAS __attribute__((address_space(3)))
typedef unsigned short bf16;
typedef unsigned u32x4 __attribute__((ext_vector_type(4)));
typedef unsigned u32x2 __attribute__((ext_vector_type(2)));
typedef float f32x4 __attribute__((ext_vector_type(4)));
typedef float f32x2 __attribute__((ext_vector_type(2)));
typedef short bf16x8 __attribute__((ext_vector_type(8)));
typedef float f32x16 __attribute__((ext_vector_type(16)));

#define XB_TMO      128
#define XB_XCNT(j)  (256  + 64 * (j))
#define XB_XSUB(j)  (1280 + 64 * (j))
#define XB_XGEN(j)  (2304 + 64 * (j))
#define XB_TOP      3328
#define XB_TOPGEN   3392
#define XCD_BAR_WORDS 3456
#define XB_SPIN_CAP (1u << 18)

__device__ __forceinline__ unsigned xb_ld(unsigned* p)              { return __hip_atomic_load(p, __ATOMIC_RELAXED, __HIP_MEMORY_SCOPE_AGENT); }
__device__ __forceinline__ unsigned xb_add(unsigned* p, unsigned v) { return __hip_atomic_fetch_add(p, v, __ATOMIC_RELAXED, __HIP_MEMORY_SCOPE_AGENT); }
__device__ __forceinline__ unsigned xb_xcc_id() { return (unsigned)__builtin_amdgcn_s_getreg((3 << 11) | 20) & 0xFu; }
#define XB_SPIN(cond, bar) do { unsigned _sp = 0; while (cond) { __builtin_amdgcn_s_sleep(1); \
    if ((++_sp & 255u) == 0u) { if (xb_ld(&(bar)[XB_TMO])) break; if (_sp > XB_SPIN_CAP) { atomicAdd(&(bar)[XB_TMO], 1u); break; } } } } while (0)

struct XcdBarrier {
    unsigned* bar; unsigned x;
    volatile LAS unsigned* st;
};

__device__ __forceinline__ XcdBarrier xcd_barrier_post(unsigned* bar, volatile LAS unsigned* st) {
    XcdBarrier b; b.bar = bar; b.x = xb_xcc_id(); b.st = st;
    if (threadIdx.x == 0) (void)xb_add(&bar[XB_XCNT(b.x)], 1u);
    return b;
}
__device__ __forceinline__ void xcd_barrier_complete(unsigned* bar, unsigned x, unsigned& nloc, unsigned& nx) {
    const unsigned G = gridDim.x * gridDim.y * gridDim.z;
    unsigned sum, cnt, mine, sp = 0u;
    for (;;) {
        sum = 0u; cnt = 0u; mine = 0u;
#pragma unroll
        for (unsigned j = 0; j < 16; ++j) { const unsigned c = xb_ld(&bar[XB_XCNT(j)]); sum += c; cnt += (c > 0u) ? 1u : 0u; mine = (j == x) ? c : mine; }
        if (sum == G) break;
        __builtin_amdgcn_s_sleep(1);
        if ((++sp & 255u) == 0u) { if (xb_ld(&bar[XB_TMO])) break; if (sp > XB_SPIN_CAP) { atomicAdd(&bar[XB_TMO], 1u); break; } }
    }
    nloc = mine > 0u ? mine : 1u; nx = cnt > 0u ? cnt : 1u;
}

__device__ __forceinline__ void xcd_barrier(const XcdBarrier& b) {
    asm volatile("s_waitcnt vmcnt(0)" ::: "memory");
    __syncthreads();
    if (threadIdx.x == 0) {
        unsigned* bar = b.bar;
        __builtin_amdgcn_s_waitcnt(0);
        unsigned nloc = b.st[0], nx = b.st[1];
        if (nloc == 0u) { xcd_barrier_complete(bar, b.x, nloc, nx); b.st[0] = nloc; b.st[1] = nx; }
        const unsigned old = xb_add(&bar[XB_XSUB(b.x)], 1u);
        const unsigned gen = old / nloc;
        if (old + 1u == (gen + 1u) * nloc) {
            __builtin_amdgcn_fence(__ATOMIC_RELEASE, "agent");
            asm volatile("s_waitcnt vmcnt(0)" ::: "memory");
            const unsigned og = xb_add(&bar[XB_TOP], 1u);
            const unsigned tg = og / nx;
            if (og + 1u == (tg + 1u) * nx) xb_add(&bar[XB_TOPGEN], 1u);
            else XB_SPIN(xb_ld(&bar[XB_TOPGEN]) == tg, bar);
            __builtin_amdgcn_fence(__ATOMIC_ACQUIRE, "agent");
            xb_add(&bar[XB_XGEN(b.x)], 1u);
            asm volatile("s_waitcnt vmcnt(0)" ::: "memory");
        } else {
            XB_SPIN(xb_ld(&bar[XB_XGEN(b.x)]) == gen, bar);
            __builtin_amdgcn_fence(__ATOMIC_ACQUIRE, "agent");
            asm volatile("s_waitcnt vmcnt(0)" ::: "memory");
        }
    }
    __syncthreads();
}

constexpr int NB = 4, T = 8192, D = 1024, M = NB * T, DEPTH = 4, INW = 1792, FF = 4096;
constexpr float EPS = 1e-6f, LOG2E = 1.4426950408889634f;
constexpr size_t MiB = 1u << 20;
constexpr size_t WS_WIN = 1 * MiB, WS_WOUT = 16 * MiB, WS_WUP = 24 * MiB, WS_WDN = 56 * MiB, WS_XB = 88 * MiB, WS_SSQ = 152 * MiB;
constexpr size_t WS_Q = 154 * MiB, WS_K = 186 * MiB, WS_V = 194 * MiB, WS_HG = 202 * MiB, WS_MIX = 234 * MiB;
constexpr size_t WS_HID = 154 * MiB, WS_END = 410 * MiB;
constexpr size_t SZ_WIN = (size_t)INW * D * 2, SZ_WOUT = (size_t)D * D * 2, SZ_WUP = (size_t)FF * D * 2, SZ_WDN = (size_t)D * FF * 2;
static_assert(WS_WIN + DEPTH * SZ_WIN <= WS_WOUT && WS_WOUT + DEPTH * SZ_WOUT <= WS_WUP && WS_WUP + DEPTH * SZ_WUP <= WS_WDN && WS_WDN + DEPTH * SZ_WDN <= WS_XB, "weights map");
static_assert(WS_XB + (size_t)M * D * 2 <= WS_SSQ && WS_SSQ + (size_t)M * 16 * 4 <= WS_Q && WS_MIX + (size_t)M * D * 2 <= WS_END && WS_HID + (size_t)M * FF * 2 <= WS_END, "activation map");
constexpr int KP = 144, VP = 528;
constexpr int L_K = 0, L_V = 2 * 256 * KP, L_BIAS = L_V + 2 * 64 * VP, L_SSQ = L_BIAS + 8 * 192 * 4, L_END = L_SSQ + 2 * 8 * 32 * 4;
constexpr int LDS_BYTES = 155648;
constexpr int MISC_OFF = LDS_BYTES - 256;
constexpr size_t WS_CTL = 0, CTL_ZERO_BYTES = 16384;
static_assert(L_END <= MISC_OFF && pg8::STAGE_BYTES <= MISC_OFF && XCD_BAR_WORDS * 4 <= (int)CTL_ZERO_BYTES, "LDS map");

__device__ __forceinline__ int tid_opaque() { int t = threadIdx.x; asm volatile("" : "+v"(t)); return t; }
template <int CTRL> __device__ __forceinline__ float dppf(float v) { return __builtin_bit_cast(float, __builtin_amdgcn_update_dpp(0, __builtin_bit_cast(int, v), CTRL, 0xf, 0xf, false)); }
__device__ __forceinline__ float wave_sum(float v) {
    v += dppf<0xB1>(v);
    v += dppf<0x4E>(v);
    v += dppf<0x141>(v);
    v += dppf<0x140>(v);
    const int vi = __builtin_bit_cast(int, v);
    const float r0 = __builtin_bit_cast(float, __builtin_amdgcn_readlane(vi, 0)), r1 = __builtin_bit_cast(float, __builtin_amdgcn_readlane(vi, 16));
    const float r2 = __builtin_bit_cast(float, __builtin_amdgcn_readlane(vi, 32)), r3 = __builtin_bit_cast(float, __builtin_amdgcn_readlane(vi, 48));
    return (r0 + r1) + (r2 + r3);
}
__device__ __forceinline__ unsigned pk2(float lo, float hi) { return pg8::cvt_pk_bf16(lo, hi); }

__device__ __forceinline__ int in_col_map(int n0) {
    if (n0 < 768) { const int pn = n0 >> 8, l = n0 & 255; return (pn << 8) + ((l >> 5) & 1) * 128 + (l >> 6) * 32; }
    if (n0 < 1280) { const int ch = n0 - 768; return ((3 + (ch >> 7)) << 8) + (ch & 127); }
    const int ch = n0 - 1280; return ((3 + (ch >> 7)) << 8) + 128 + (ch & 127);
}
__device__ __forceinline__ void transpose_item(const float* W, int K, int N, bf16* WT, const float* g0, const float* g1, bool inmap, LAS float* scr, int item, int lane, bool stream) {
    const int nblk = N / 32, kb = item / nblk, nb = item % nblk, k0 = 64 * kb, n0 = 32 * nb;
    float wv[32];
#pragma unroll
    for (int i = 0; i < 32; ++i) wv[i] = __builtin_nontemporal_load(W + (size_t)(k0 + 2 * i + (lane >> 5)) * N + n0 + (lane & 31));
#pragma unroll
    for (int i = 0; i < 32; ++i) { const int kk = 2 * i + (lane >> 5), k = k0 + kk; const float g = g0 ? (k < 512 ? g0[k] : g1[k - 512]) : 1.0f;
        scr[kk * 33 + (lane & 31)] = wv[i] * g; }
    asm volatile("s_waitcnt lgkmcnt(0)" ::: "memory");
    const int c = lane & 7, d0 = inmap ? in_col_map(n0) : n0;
    float tv[4][8];
#pragma unroll
    for (int j = 0; j < 4; ++j)
#pragma unroll
        for (int i = 0; i < 8; ++i) tv[j][i] = scr[(8 * c + i) * 33 + (lane >> 3) + 8 * j];
    __builtin_amdgcn_sched_barrier(0);
#pragma unroll
    for (int j = 0; j < 4; ++j) { const int n = (lane >> 3) + 8 * j;
        u32x4 o; o.x = pk2(tv[j][0], tv[j][1]); o.y = pk2(tv[j][2], tv[j][3]); o.z = pk2(tv[j][4], tv[j][5]); o.w = pk2(tv[j][6], tv[j][7]);
        if (stream) __builtin_nontemporal_store(o, (u32x4*)(WT + (size_t)(d0 + n) * K + k0 + 8 * c)); else *(u32x4*)(WT + (size_t)(d0 + n) * K + k0 + 8 * c) = o; }
    asm volatile("s_waitcnt lgkmcnt(0)" ::: "memory");
}

struct Args {
    const float* x; const float* rel_bias; const float* norm_mix_g; const float* w_in; const float* q_norm_g; const float* k_norm_g; const float* sinks;
    const float* conv_w; const float* conv_b; const float* conv_ln_g; const float* conv_ln_b; const float* attn_out_g; const float* conv_out_g; const float* w_out;
    const float* norm_mlp_g; const float* w_mlp_up; const float* w_mlp_down;
    float* out; unsigned char* ws; int ph_lo, ph_hi;
};

__device__ __forceinline__ void convert_layer(const Args& a, LAS unsigned char* lds, int l, int gw, int NGW) {
    const int tid = tid_opaque(), lane = tid & 63, wave = tid >> 6;
    LAS float* scr = (LAS float*)(lds + wave * 16384);
    constexpr int I_IN = (D / 64) * (INW / 32), I_OUT = (D / 64) * (D / 32), I_UP = (D / 64) * (FF / 32), I_DN = (FF / 64) * (D / 32), I_L = I_IN + I_OUT + I_UP + I_DN;
    for (int it = gw; it < I_L; it += NGW) {
        int r = it;
        if (r < I_IN) { transpose_item(a.w_in + (size_t)l * D * INW, D, INW, (bf16*)(a.ws + WS_WIN + l * SZ_WIN), a.norm_mix_g + l * D, a.norm_mix_g + l * D + 512, true, scr, r, lane, l > 0); continue; } r -= I_IN;
        if (r < I_OUT) { transpose_item(a.w_out + (size_t)l * D * D, D, D, (bf16*)(a.ws + WS_WOUT + l * SZ_WOUT), a.attn_out_g + l * 512, a.conv_out_g + l * 512, false, scr, r, lane, l > 0); continue; } r -= I_OUT;
        if (r < I_UP) { transpose_item(a.w_mlp_up + (size_t)l * D * FF, D, FF, (bf16*)(a.ws + WS_WUP + l * SZ_WUP), a.norm_mlp_g + l * D, a.norm_mlp_g + l * D + 512, false, scr, r, lane, l > 0); continue; } r -= I_UP;
        transpose_item(a.w_mlp_down + (size_t)l * FF * D, FF, D, (bf16*)(a.ws + WS_WDN + l * SZ_WDN), nullptr, nullptr, false, scr, r, lane, l > 0);
    }
}
__device__ __forceinline__ void prologue(const Args& a, LAS unsigned char* lds, int vcu, int G) {
    const int tid = tid_opaque(), lane = tid & 63, wave = tid >> 6;
    const int gw = vcu * 8 + wave, NGW = G * 8;
    convert_layer(a, lds, 0, gw, NGW);
    bf16* xb = (bf16*)(a.ws + WS_XB); float* ssq = (float*)(a.ws + WS_SSQ);
    const int rpb = M / G, rbase = vcu * rpb;
    for (int m0 = rbase + wave * 4; m0 < rbase + rpb; m0 += 32) {
        f32x4 v[4][4]; float s[4];
#pragma unroll
        for (int q = 0; q < 4; ++q) { const f32x4* xr = (const f32x4*)(a.x + (size_t)(m0 + q) * D) + lane;
#pragma unroll
            for (int j = 0; j < 4; ++j) v[q][j] = __builtin_nontemporal_load(xr + 64 * j); }
#pragma unroll
        for (int q = 0; q < 4; ++q) { float t = 0.f;
#pragma unroll
            for (int j = 0; j < 4; ++j) t += (v[q][j][0] * v[q][j][0] + v[q][j][1] * v[q][j][1]) + (v[q][j][2] * v[q][j][2] + v[q][j][3] * v[q][j][3]);
            s[q] = wave_sum(t); }
#pragma unroll
        for (int q = 0; q < 4; ++q) { u32x2* o8 = (u32x2*)(xb + (size_t)(m0 + q) * D) + lane;
#pragma unroll
            for (int j = 0; j < 4; ++j) { u32x2 w; w.x = pk2(v[q][j][0], v[q][j][1]); w.y = pk2(v[q][j][2], v[q][j][3]); o8[64 * j] = w; } }
        { const int q = lane >> 4, c = lane & 15; const float sq = q == 0 ? s[0] : q == 1 ? s[1] : q == 2 ? s[2] : s[3]; ssq[(size_t)(m0 + q) * 16 + c] = c == 0 ? sq : 0.f; }
    }
}

__device__ __forceinline__ void attn_bias_table(LAS unsigned char* lds, const float* rel_bias) {
    LAS float* bt = (LAS float*)(lds + L_BIAS);
    for (int i = tid_opaque(); i < 8 * 192; i += 512) { const int h = i / 192, dist = 159 - i % 192; float v = 0.f;
        if (dist >= 0 && dist < 128) { int bk = dist; if (dist >= 16) { bk = 16 + (int)(__log2f((float)dist * 0.0625f) * (16.0f / 3.0f)); bk = bk < 31 ? bk : 31; } v = rel_bias[bk * 8 + h] * LOG2E; }
        bt[i] = v; }
}
__device__ __forceinline__ void attn_stage(LAS unsigned char* lds, int b, int qb, const bf16* Kb, const bf16* Vg) {
    const int tid = tid_opaque(), tok0 = qb * 128 - 128;
#pragma unroll
    for (int it = 0; it < 8; ++it) { const int c = it * 512 + tid, kb = c >> 4, sub = c & 15, tok = tok0 + kb;
        u32x4 v = (u32x4){0u, 0u, 0u, 0u}; if (tok >= 0) v = *(const u32x4*)(Kb + ((size_t)b * T + tok) * 128 + sub * 8);
        *(LAS u32x4*)(lds + L_K + (sub >> 3) * 256 * KP + kb * KP + (sub & 7) * 16) = v; }
#pragma unroll
    for (int it = 0; it < 8; ++it) { const int c = it * 512 + tid, kb = c & 255, grp = c >> 8, tok = tok0 + kb;
        u32x4 v = (u32x4){0u, 0u, 0u, 0u}; if (tok >= 0) v = *(const u32x4*)(Vg + ((size_t)(b * 16 + grp) * T + tok) * 8);
        const int pos = (kb & ~12) | ((kb & 4) << 1) | ((kb & 8) >> 1);
        LAS unsigned short* d = (LAS unsigned short*)(lds + L_V + (grp >> 3) * 64 * VP + (grp & 7) * 8 * VP + pos * 2);
        d[0 * (VP / 2)] = (unsigned short)(v.x & 0xffffu); d[1 * (VP / 2)] = (unsigned short)(v.x >> 16);
        d[2 * (VP / 2)] = (unsigned short)(v.y & 0xffffu); d[3 * (VP / 2)] = (unsigned short)(v.y >> 16);
        d[4 * (VP / 2)] = (unsigned short)(v.z & 0xffffu); d[5 * (VP / 2)] = (unsigned short)(v.z >> 16);
        d[6 * (VP / 2)] = (unsigned short)(v.w & 0xffffu); d[7 * (VP / 2)] = (unsigned short)(v.w >> 16); }
}
__device__ __forceinline__ void attn_compute(LAS unsigned char* lds, int b, int qb, const bf16* Q, bf16* mix, const float* sinks_l) {
    const int tid = tid_opaque(), lane = tid & 63, r32 = lane & 31, hi = lane >> 5;
    const int h = __builtin_amdgcn_readfirstlane(tid >> 6), kvh = h >> 2;
    const LAS float* bR = (const LAS float*)(lds + L_BIAS) + h * 192 + 31 - (r32 - 4 * hi);
    const LAS unsigned char* Kl = lds + L_K + kvh * 256 * KP + r32 * KP + hi * 16;
    const LAS unsigned char* Vl = lds + L_V + kvh * 64 * VP + r32 * VP + hi * 16;
    const size_t rowbase = (size_t)b * T + (size_t)qb * 128;
    const int jmin = (qb == 0) ? 4 : 0;
    const float sink2 = sinks_l[h] * LOG2E;
    const bf16* qp = Q + (rowbase + r32) * 512 + h * 64 + hi * 8;
    bf16x8 qn[4];
#pragma unroll
    for (int ds = 0; ds < 4; ++ds) qn[ds] = *(const bf16x8*)(qp + ds * 16);
#pragma unroll 1
    for (int rb = 0; rb < 4; ++rb) {
        bf16x8 qf[4];
#pragma unroll
        for (int ds = 0; ds < 4; ++ds) qf[ds] = qn[ds];
        if (rb < 3) {
#pragma unroll
            for (int ds = 0; ds < 4; ++ds) qn[ds] = *(const bf16x8*)(qp + (size_t)(rb + 1) * 32 * 512 + ds * 16);
        }
        f32x16 s[5];
        bf16x8 kf[2][4];
#pragma unroll
        for (int ds = 0; ds < 4; ++ds) kf[0][ds] = *(const LAS bf16x8*)(Kl + (32 * rb) * KP + ds * 32);
#pragma unroll
        for (int j = 0; j < 5; ++j) {
            if (j < 4) {
#pragma unroll
                for (int ds = 0; ds < 4; ++ds) kf[(j + 1) & 1][ds] = *(const LAS bf16x8*)(Kl + (32 * (rb + j + 1)) * KP + ds * 32);
            }
            __builtin_amdgcn_sched_barrier(0);
            const float s0 = ((rb + j) >= jmin) ? 0.f : -1e30f;
#pragma unroll
            for (int r = 0; r < 16; ++r) s[j][r] = s0;
#pragma unroll
            for (int ds = 0; ds < 4; ++ds) s[j] = __builtin_amdgcn_mfma_f32_32x32x16_bf16(kf[j & 1][ds], qf[ds], s[j], 0, 0, 0);
            __builtin_amdgcn_sched_barrier(0);
        }
        float mx = sink2;
        const int tq = r32 - 4 * hi;
        f32x2 sv[5][8];
        f32x2 bz[2][8];
#pragma unroll
        for (int r2 = 0; r2 < 8; ++r2) { const int kc = ((2 * r2) & 3) + 8 * ((2 * r2) >> 2); bz[0][r2] = (f32x2){bR[kc], bR[kc + 1]}; }
#pragma unroll
        for (int j = 0; j < 5; ++j) {
            if (j < 4) {
#pragma unroll
                for (int r2 = 0; r2 < 8; ++r2) { const int kc = ((2 * r2) & 3) + 8 * ((2 * r2) >> 2); bz[(j + 1) & 1][r2] = (f32x2){bR[32 * (j + 1) + kc], bR[32 * (j + 1) + kc + 1]}; }
            }
            __builtin_amdgcn_sched_barrier(0);
#pragma unroll
            for (int r2 = 0; r2 < 8; ++r2) { const int r = 2 * r2, kc = (r & 3) + 8 * (r >> 2);
                f32x2 v = (f32x2){s[j][r], s[j][r + 1]} + bz[j & 1][r2];
                if (j == 0) v += (f32x2){(kc > tq) ? 0.f : -1e30f, (kc + 1 > tq) ? 0.f : -1e30f};
                if (j == 4) v += (f32x2){(kc <= tq) ? 0.f : -1e30f, (kc + 1 <= tq) ? 0.f : -1e30f};
                sv[j][r2] = v; mx = fmaxf(mx, fmaxf(v[0], v[1])); }
            __builtin_amdgcn_sched_barrier(0);
        }
        { const auto sw = __builtin_amdgcn_permlane32_swap(__float_as_uint(mx), __float_as_uint(mx), false, false); mx = fmaxf(__uint_as_float(sw[0]), __uint_as_float(sw[1])); }
        f32x2 l2 = (f32x2){0.f, 0.f}; const f32x2 mx2 = (f32x2){mx, mx};
        f32x16 o[2];
#pragma unroll
        for (int r = 0; r < 16; ++r) { o[0][r] = 0.f; o[1][r] = 0.f; }
        bf16x8 vf[2][4];
#pragma unroll
        for (int q = 0; q < 4; ++q) vf[0][q] = *(const LAS bf16x8*)(Vl + (q & 1) * 32 * VP + (32 * rb + 16 * (q >> 1)) * 2);
#pragma unroll
        for (int j = 0; j < 5; ++j) {
            if (j < 4) {
#pragma unroll
                for (int q = 0; q < 4; ++q) vf[(j + 1) & 1][q] = *(const LAS bf16x8*)(Vl + (q & 1) * 32 * VP + (32 * (rb + j + 1) + 16 * (q >> 1)) * 2);
            }
            __builtin_amdgcn_sched_barrier(0);
#pragma unroll
            for (int r2 = 0; r2 < 8; ++r2) { const f32x2 d = sv[j][r2] - mx2; f32x2 p; p[0] = __builtin_amdgcn_exp2f(d[0]); p[1] = __builtin_amdgcn_exp2f(d[1]); sv[j][r2] = p; l2 += p; }
#pragma unroll
            for (int sh = 0; sh < 2; ++sh) {
                u32x4 pw; pw.x = pk2(sv[j][4 * sh + 0][0], sv[j][4 * sh + 0][1]); pw.y = pk2(sv[j][4 * sh + 1][0], sv[j][4 * sh + 1][1]); pw.z = pk2(sv[j][4 * sh + 2][0], sv[j][4 * sh + 2][1]); pw.w = pk2(sv[j][4 * sh + 3][0], sv[j][4 * sh + 3][1]);
                const bf16x8 pf = __builtin_bit_cast(bf16x8, pw);
#pragma unroll
                for (int dt = 0; dt < 2; ++dt) o[dt] = __builtin_amdgcn_mfma_f32_32x32x16_bf16(vf[j & 1][sh * 2 + dt], pf, o[dt], 0, 0, 0);
            }
            __builtin_amdgcn_sched_barrier(0);
        }
        float l = l2[0] + l2[1];
        { const auto sw = __builtin_amdgcn_permlane32_swap(__float_as_uint(l), __float_as_uint(l), false, false); l = __uint_as_float(sw[0]) + __uint_as_float(sw[1]); }
        l += __builtin_amdgcn_exp2f(sink2 - mx);
        const float inv = __builtin_amdgcn_rcpf(l);
        f32x2 ov[2][8]; f32x2 ss2 = (f32x2){0.f, 0.f}; const f32x2 inv2 = (f32x2){inv, inv};
#pragma unroll
        for (int dt = 0; dt < 2; ++dt)
#pragma unroll
            for (int r2 = 0; r2 < 8; ++r2) { ov[dt][r2] = (f32x2){o[dt][2 * r2], o[dt][2 * r2 + 1]} * inv2; ss2 += ov[dt][r2] * ov[dt][r2]; }
        float ss = ss2[0] + ss2[1];
        { const auto sw = __builtin_amdgcn_permlane32_swap(__float_as_uint(ss), __float_as_uint(ss), false, false); ss = __uint_as_float(sw[0]) + __uint_as_float(sw[1]); }
        LAS float* X = (LAS float*)(lds + L_SSQ) + (rb & 1) * 256;
        if (hi == 0) X[h * 32 + r32] = ss;
        __syncthreads();
        float tot = 0.f;
#pragma unroll
        for (int hh = 0; hh < 8; ++hh) tot += X[hh * 32 + r32];
        const float rr = rsqrtf(tot * (1.0f / 512.0f) + EPS);
        bf16* op = mix + (rowbase + rb * 32 + r32) * 1024 + h * 64 + 8 * hi;
        const f32x2 rr2 = (f32x2){rr, rr};
#pragma unroll
        for (int dt = 0; dt < 2; ++dt)
#pragma unroll
            for (int k = 0; k < 4; k += 2) {
                const f32x2 a0 = ov[dt][2 * k] * rr2, a1 = ov[dt][2 * k + 1] * rr2, b0 = ov[dt][2 * k + 2] * rr2, b1 = ov[dt][2 * k + 3] * rr2;
                unsigned ax = pk2(a0[0], a0[1]), ay = pk2(a1[0], a1[1]), bx_ = pk2(b0[0], b0[1]), by = pk2(b1[0], b1[1]);
                { const auto r = __builtin_amdgcn_permlane32_swap(ax, bx_, false, false); ax = r[0]; bx_ = r[1]; }
                { const auto r = __builtin_amdgcn_permlane32_swap(ay, by, false, false); ay = r[0]; by = r[1]; }
                u32x4 w; w.x = ax; w.y = ay; w.z = bx_; w.w = by;
                *(u32x4*)(op + dt * 32 + 8 * k) = w; }
    }
}

constexpr int CT = 16, CWIN = CT + 30, CITEM = 2 * CT;
template <int S> __device__ __forceinline__ unsigned conv_ld(const bf16* hp, int tt) {
    unsigned hv = 0u; if (S >= 30 || tt - 30 + S >= 0) hv = *(const unsigned*)(hp + (long)S * 512); return hv;
}
template <int S> __device__ __forceinline__ void conv_fma(f32x2 (&acc)[CT], const f32x2 (&w)[31], unsigned hv) {
    f32x2 hf; hf[0] = __uint_as_float(hv << 16); hf[1] = __uint_as_float(hv & 0xffff0000u);
#pragma unroll
    for (int j = 0; j < 31; ++j) { const int tok = S - j; if (tok >= 0 && tok < CT) acc[tok] += w[j] * hf; }
}
template <int... I> __device__ __forceinline__ void conv_load_all(std::integer_sequence<int, I...>, unsigned (&hv)[CWIN], const bf16* hp, int tt) { ((hv[I] = conv_ld<I>(hp, tt)), ...); }
template <int... I> __device__ __forceinline__ void conv_fma_all(std::integer_sequence<int, I...>, f32x2 (&acc)[CT], const f32x2 (&w)[31], const unsigned (&hv)[CWIN]) { (conv_fma<I>(acc, w, hv[I]), ...); }
__device__ __forceinline__ void conv_weights(f32x2 (&w)[31], f32x2& bias, const float* cw, const float* cb) {
    const int cp = tid_opaque() & 255;
#pragma unroll
    for (int j = 0; j < 31; ++j) w[j] = *(const f32x2*)(cw + j * 512 + 2 * cp);
    bias = *(const f32x2*)(cb + 2 * cp);
}
__device__ __forceinline__ void conv_phase(LAS unsigned char* lds, int bx, int G, const bf16* Hg, const float* cw, const float* cb, const float* lg, const float* lb, bf16* mix) {
    const int tid = tid_opaque(), cp = tid & 255, half = tid >> 8, lane = tid & 63, wave = tid >> 6;
    constexpr int NIT = M / CITEM;
    f32x2 w[31]; f32x2 bias; conv_weights(w, bias, cw, cb);
    const f32x4 g0 = *(const f32x4*)(lg + lane * 8), g1 = *(const f32x4*)(lg + lane * 8 + 4), b0 = *(const f32x4*)(lb + lane * 8), b1 = *(const f32x4*)(lb + lane * 8 + 4);
    unsigned hv[CWIN];
    const int per = (NIT + G - 1) / G, itend = (bx + 1) * per < NIT ? (bx + 1) * per : NIT;
    int it = bx * per, par = 0;
    if (it < itend) { const int ts = it * CITEM + half * CT; conv_load_all(std::make_integer_sequence<int, CWIN>{}, hv, Hg + ((long)ts - 30) * 512 + 2 * cp, ts & (T - 1)); }
#pragma unroll 1
    for (; it < itend; ++it, par ^= 1) {
        f32x2 acc[CT];
#pragma unroll
        for (int k = 0; k < CT; ++k) acc[k] = bias;
        conv_fma_all(std::make_integer_sequence<int, CWIN>{}, acc, w, hv);
        LAS float* Y = (LAS float*)lds + par * (CITEM * 512);
#pragma unroll
        for (int k = 0; k < CT; ++k) *(LAS f32x2*)(Y + (half * CT + k) * 512 + 2 * cp) = acc[k];
        { const int nit = it + 1; if (nit < itend) { const int ts = nit * CITEM + half * CT; conv_load_all(std::make_integer_sequence<int, CWIN>{}, hv, Hg + ((long)ts - 30) * 512 + 2 * cp, ts & (T - 1)); } }
        __syncthreads();
        constexpr int NT = CITEM / 8;
        f32x4 y0[NT], y1[NT]; float red[NT];
#pragma unroll
        for (int k = 0; k < NT; ++k) { const int tok = wave * NT + k; y0[k] = *(const LAS f32x4*)(Y + tok * 512 + lane * 8); y1[k] = *(const LAS f32x4*)(Y + tok * 512 + lane * 8 + 4); }
#pragma unroll
        for (int k = 0; k < NT; ++k) red[k] = ((y0[k][0] + y0[k][1]) + (y0[k][2] + y0[k][3])) + ((y1[k][0] + y1[k][1]) + (y1[k][2] + y1[k][3]));
#pragma unroll
        for (int k = 0; k < NT; ++k) red[k] = wave_sum(red[k]) * (1.0f / 512.0f);
#pragma unroll
        for (int k = 0; k < NT; ++k) { y0[k] = y0[k] - red[k]; y1[k] = y1[k] - red[k]; const f32x4 q0 = y0[k] * y0[k], q1 = y1[k] * y1[k]; red[k] = ((q0[0] + q0[1]) + (q0[2] + q0[3])) + ((q1[0] + q1[1]) + (q1[2] + q1[3])); }
#pragma unroll
        for (int k = 0; k < NT; ++k) red[k] = rsqrtf(wave_sum(red[k]) * (1.0f / 512.0f) + EPS);
#pragma unroll
        for (int k = 0; k < NT; ++k) { y0[k] = y0[k] * red[k] * g0 + b0; y1[k] = y1[k] * red[k] * g1 + b1; float ss = 0.f;
#pragma unroll
            for (int i = 0; i < 4; ++i) { y0[k][i] = y0[k][i] * __builtin_amdgcn_rcpf(1.0f + __expf(-y0[k][i])); y1[k][i] = y1[k][i] * __builtin_amdgcn_rcpf(1.0f + __expf(-y1[k][i])); ss += y0[k][i] * y0[k][i] + y1[k][i] * y1[k][i]; }
            red[k] = ss; }
#pragma unroll
        for (int k = 0; k < NT; ++k) red[k] = rsqrtf(wave_sum(red[k]) * (1.0f / 512.0f) + EPS);
#pragma unroll
        for (int k = 0; k < NT; ++k) { const int tok = wave * NT + k; const float rr = red[k];
            u32x4 o; o.x = pk2(y0[k][0] * rr, y0[k][1] * rr); o.y = pk2(y0[k][2] * rr, y0[k][3] * rr); o.z = pk2(y1[k][0] * rr, y1[k][1] * rr); o.w = pk2(y1[k][2] * rr, y1[k][3] * rr);
            *(u32x4*)(mix + ((size_t)it * CITEM + tok) * 1024 + 512 + lane * 8) = o; }
    }
    __syncthreads();
}

#ifndef MK_N_LAUNCHES
#define MK_N_LAUNCHES 1
#endif
#ifndef MLP_SPLIT
#define MLP_SPLIT 2
#endif
constexpr int PPL = 3 + 2 * MLP_SPLIT, NPHASE = 1 + PPL * DEPTH;
__global__ void __launch_bounds__(512, 2) fwd_kernel(Args a) {
    extern __shared__ __attribute__((aligned(16))) unsigned char lds_raw[];
    LAS unsigned char* lds = (LAS unsigned char*)lds_raw;
    cg::grid_group grid = cg::this_grid();
    const int G = gridDim.x, bx = blockIdx.x, vcu = (G % 8 == 0) ? (bx % 8) * (G / 8) + bx / 8 : bx;
    const int lo = a.ph_lo, hi = a.ph_hi;
#define IN(k) (lo <= (k) && (k) < hi)
    volatile LAS unsigned* MISC = (volatile LAS unsigned*)(lds + MISC_OFF);
    if (threadIdx.x < 64) MISC[threadIdx.x] = 0u;
    __syncthreads();
    XcdBarrier bar; bar.bar = (unsigned*)(a.ws + WS_CTL); bar.x = 0; bar.st = nullptr;
    if (hi - lo > 1) bar = xcd_barrier_post((unsigned*)(a.ws + WS_CTL), MISC + 8);
#define SEAM(k) do { if ((k) + 1 < hi) { if ((k) == 0) grid.sync(); else xcd_barrier(bar); } } while (0)
    bf16* xb = (bf16*)(a.ws + WS_XB); float* ssq = (float*)(a.ws + WS_SSQ);
    bf16* Qb = (bf16*)(a.ws + WS_Q); bf16* Kb = (bf16*)(a.ws + WS_K); bf16* Vg = (bf16*)(a.ws + WS_V); bf16* Hg = (bf16*)(a.ws + WS_HG); bf16* mix = (bf16*)(a.ws + WS_MIX); bf16* hid = (bf16*)(a.ws + WS_HID);
    if (IN(0)) { prologue(a, lds, vcu, G); __syncthreads(); SEAM(0); }
#pragma unroll 1
    for (int l = 0; l < DEPTH; ++l) {
        const int k0 = 1 + PPL * l;
        if (IN(k0)) {
            pg8::Gemm g{xb, (const bf16*)(a.ws + WS_WIN + l * SZ_WIN), M, INW, D}; pg8::StaticOrder S; S.init(M, INW, G, bx);
            pg8::EpiIn E{ssq, a.q_norm_g + l * 64, a.k_norm_g + l * 64, Qb, Kb, Vg, Hg};
            pg8::gemm_phase<pg8::EpiIn, pg8::StaticOrder, true, true, true>(lds, g, S, E);
            if (l + 1 < DEPTH) {
                constexpr int NU = (M / 256) * (INW / 256); const int rounds = (NU + G - 1) / G, nlast = NU - (rounds - 1) * G, first = (nlast >= G) ? 0 : nlast;
                if (bx >= first) convert_layer(a, lds, l + 1, (bx - first) * 8 + (tid_opaque() >> 6), (G - first) * 8);
            }
            SEAM(k0);
        }
        if (IN(k0 + 1)) {
            attn_bias_table(lds, a.rel_bias);
            for (int it = vcu; it < NB * (T / 128); it += G) { const int b = it / (T / 128), qb = it % (T / 128);
                __syncthreads(); attn_stage(lds, b, qb, Kb, Vg); __syncthreads();
                attn_compute(lds, b, qb, Qb, mix, a.sinks + l * 8); }
            __syncthreads();
            conv_phase(lds, vcu, G, Hg, a.conv_w + (size_t)l * 31 * 512, a.conv_b + l * 512, a.conv_ln_g + l * 512, a.conv_ln_b + l * 512, mix);
            SEAM(k0 + 1);
        }
        if (IN(k0 + 2)) {
            pg8::Gemm g{mix, (const bf16*)(a.ws + WS_WOUT + l * SZ_WOUT), M, D, D}; pg8::StaticOrder S; S.init(M, D, G, bx);
#if RES_BF16
            pg8::EpiRes E{nullptr, nullptr, xb, ssq};
#else
            pg8::EpiRes E{l == 0 ? a.x : a.out, a.out, xb, ssq};
#endif
            pg8::gemm_phase<pg8::EpiRes, pg8::StaticOrder, true, true, true>(lds, g, S, E);
            SEAM(k0 + 2);
        }
#pragma unroll 1
        for (int hf = 0; hf < MLP_SPLIT; ++hf) {
            constexpr int MS = M / MLP_SPLIT; const size_t r0 = (size_t)hf * MS;
            const int ku = k0 + 3 + 2 * hf, kd = ku + 1;
            if (IN(ku)) {
                pg8::Gemm g{xb + r0 * D, (const bf16*)(a.ws + WS_WUP + l * SZ_WUP), MS, FF, D}; pg8::StaticOrder S; S.init(MS, FF, G, bx);
                pg8::EpiUp E{ssq + r0 * 16, hid};
                pg8::gemm_phase<pg8::EpiUp, pg8::StaticOrder, true, true, true>(lds, g, S, E);
                SEAM(ku);
            }
            if (IN(kd)) {
                pg8::Gemm g{hid, (const bf16*)(a.ws + WS_WDN + l * SZ_WDN), MS, D, FF}; pg8::StaticOrder S; S.init(MS, D, G, bx);
#if RES_BF16
                pg8::EpiRes E{nullptr, l == DEPTH - 1 ? a.out + r0 * D : nullptr, xb + r0 * D, ssq + r0 * 16};
#else
                pg8::EpiRes E{a.out + r0 * D, a.out + r0 * D, xb + r0 * D, ssq + r0 * 16};
#endif
                pg8::gemm_phase<pg8::EpiRes, pg8::StaticOrder, true, true, true>(lds, g, S, E);
                SEAM(kd);
            }
        }
    }
#undef IN
#undef SEAM
}

extern "C" void kernel_launch(void* const* d_in, const int* in_sizes, int n_in, void* d_out, int out_size, void* d_ws, size_t ws_size, hipStream_t stream) {
    static int grid = 0;
    if (grid == 0) {
        if (n_in != 17 || in_sizes[0] != M * D || out_size != M * D || ws_size < WS_END) { fprintf(stderr, "kernel_launch: unexpected shapes (n_in %d, in0 %d, out %d, ws %zu); nothing launched\n", n_in, n_in > 0 ? in_sizes[0] : -1, out_size, ws_size); grid = -1; return; }
        int dev = 0, cus = 0, per_cu = 0;
        if (hipGetDevice(&dev) != hipSuccess || hipDeviceGetAttribute(&cus, hipDeviceAttributeMultiprocessorCount, dev) != hipSuccess) { grid = -1; return; }
        if (hipFuncSetAttribute((const void*)fwd_kernel, hipFuncAttributeMaxDynamicSharedMemorySize, LDS_BYTES) != hipSuccess) { fprintf(stderr, "kernel_launch: hipFuncSetAttribute failed\n"); grid = -1; return; }
        if (hipOccupancyMaxActiveBlocksPerMultiprocessor(&per_cu, (const void*)fwd_kernel, 512, LDS_BYTES) != hipSuccess || per_cu < 1) { fprintf(stderr, "kernel_launch: occupancy query says %d\n", per_cu); per_cu = 1; }
        (void)hipGetLastError();
        grid = cus * per_cu;
        if (M % grid != 0 || (M / grid) % 32 != 0) { fprintf(stderr, "kernel_launch: grid %d does not divide the rows into 32-row multiples; nothing launched\n", grid); grid = -1; return; }
    }
    if (grid < 0) return;
    Args a{};
    const float** p = (const float**)&a;
    for (int i = 0; i < 17; ++i) p[i] = (const float*)d_in[i];
    a.out = (float*)d_out; a.ws = (unsigned char*)d_ws;
#if MK_N_LAUNCHES == 1
    if (hipMemsetAsync((char*)d_ws + WS_CTL, 0, CTL_ZERO_BYTES, stream) != hipSuccess) { fprintf(stderr, "kernel_launch: memset of the barrier words failed\n"); return; }
    a.ph_lo = 0; a.ph_hi = NPHASE;
    void* args[] = {&a};
    hipError_t e = hipLaunchCooperativeKernel((const void*)fwd_kernel, dim3(grid), dim3(512), args, LDS_BYTES, stream);
    if (e != hipSuccess) fprintf(stderr, "kernel_launch: cooperative launch failed: %s (grid %d)\n", hipGetErrorString(e), grid);
#else
    for (int ph = 0; ph < NPHASE; ++ph) { a.ph_lo = ph; a.ph_hi = ph + 1; hipLaunchKernelGGL(fwd_kernel, dim3(grid), dim3(512), LDS_BYTES, stream, a); }
#endif
}
```

```cpp
#include <hip/hip_runtime.h>
#include <hip/hip_cooperative_groups.h>
#include <cstdio>
#include <cstdint>
#include <utility>
namespace cg = cooperative_groups;
namespace pg8 {
#define PG8_LAS __attribute__((address_space(3)))
typedef unsigned short bf16_t;
typedef short bf16x8 __attribute__((ext_vector_type(8)));
typedef float f32x4 __attribute__((ext_vector_type(4)));
typedef unsigned u32x4 __attribute__((ext_vector_type(4)));
constexpr int BM = 256, BK = 64, HALF = 128, HTB = HALF * BK * 2  , STAGE_BYTES = 8 * HTB, NXCD = 8, WGM = 8;

__host__ __device__ __forceinline__ int lds_byte(int r, int c) { const int st = (r >> 4) * 2 + (c >> 5), rr = r & 15, cc = c & 31, ob = rr * 64 + cc * 2; return st * 1024 + (ob ^ (((ob >> 9) & 1) << 5)); }
__host__ __device__ __forceinline__ void stage_rc(int b, int& R, int& C) { const int st = b / 1024, sb = b % 1024, swz = sb ^ (((sb >> 9) & 1) << 5); R = (st >> 1) * 16 + swz / 64; C = (st & 1) * 32 + (swz % 64) / 2; }
__host__ __device__ __forceinline__ int perm32(int rho) { const int n = rho >> 4, i = rho & 15; return 8 * (i >> 2) + 4 * n + (i & 3); }

struct Unit { int pm, pn; };
struct Gemm { const bf16_t* A; const bf16_t* Bt; int M, N, K; };

struct StaticOrder {
    int nM, nN, nwg, G, c;
    __host__ __device__ void init(int M, int N, int G_, int c_) { nM = M / BM; nN = N / BM; nwg = nM * nN; G = G_; c = c_; }
    __host__ __device__ bool next(int i, Unit& u) const {
        const long L = (long)i * G + c; if (L >= nwg) return false;
        int wgid = (int)L; { const int q = nwg / NXCD, r = nwg % NXCD, xcd = wgid % NXCD, off = wgid / NXCD; wgid = (xcd < r ? xcd * (q + 1) : r * (q + 1) + (xcd - r) * q) + off; }
        const int nig = WGM * nN, gid = wgid / nig, fm = gid * WGM, gsz = (nM - fm) < WGM ? (nM - fm) : WGM;
        u.pm = fm + ((wgid % nig) % gsz); u.pn = (wgid % nig) / gsz; return true;
    }
    __device__ __forceinline__ void a_ready(const Unit&) const {}
    __device__ __forceinline__ void done(const Unit&) const {}
};

__device__ __forceinline__ unsigned cvt_pk_bf16(float lo, float hi) { unsigned r; asm volatile("v_cvt_pk_bf16_f32 %0, %1, %2" : "=v"(r) : "v"(lo), "v"(hi)); return r; }
typedef float f32x2 __attribute__((ext_vector_type(2)));
constexpr float EPS_ = 1e-6f;
constexpr int TT = 8192;
constexpr float QSCALE = 0.125f * 1.4426950408889634f;
__device__ __forceinline__ float xsum4(float s) {
    const auto a = __builtin_amdgcn_permlane16_swap(__float_as_uint(s), __float_as_uint(s), false, false); s = __uint_as_float(a[0]) + __uint_as_float(a[1]);
    const auto b = __builtin_amdgcn_permlane32_swap(__float_as_uint(s), __float_as_uint(s), false, false); return __uint_as_float(b[0]) + __uint_as_float(b[1]);
}
__device__ __forceinline__ float row_rstd(const float* ssq, int row, int fq) {
    const f32x4 p = *(const f32x4*)(ssq + (size_t)row * 16 + fq * 4);
    float s = (p[0] + p[1]) + (p[2] + p[3]); s = xsum4(s);
    return rsqrtf(s * (1.0f / 1024.0f) + EPS_);
}
__device__ __forceinline__ u32x4 pack8(const f32x4 a, const f32x4 b) { u32x4 w; w.x = cvt_pk_bf16(a[0], a[1]); w.y = cvt_pk_bf16(a[2], a[3]); w.z = cvt_pk_bf16(b[0], b[1]); w.w = cvt_pk_bf16(b[2], b[3]); return w; }

__device__ __forceinline__ void zero_acc(f32x4 (&acc)[2][2][4][2]) {
#pragma unroll
    for (int a = 0; a < 2; ++a)
#pragma unroll
        for (int b = 0; b < 2; ++b)
#pragma unroll
            for (int m = 0; m < 4; ++m)
#pragma unroll
                for (int n = 0; n < 2; ++n) acc[a][b][m][n] = (f32x4){0.f, 0.f, 0.f, 0.f};
}
struct EpiIn {
    static constexpr bool PERM = true, AFTER_DRAIN = false;
    const float* ssq; const float* qg; const float* kg;
    bf16_t* Q; bf16_t* Kb; bf16_t* Vg; bf16_t* Hg;
    __device__ __forceinline__ void init(f32x4 (&acc)[2][2][4][2], const Unit&, int, int, int, int) const { zero_acc(acc); }
    __device__ __forceinline__ void operator()(const f32x4 (&acc)[2][2][4][2], const Unit& u, int wr, int wc, int fr, int fq) const {
        const int pn = u.pn;
        float rsv[2][4];
        { f32x4 pv[2][4];
#pragma unroll
          for (int ai = 0; ai < 2; ++ai)
#pragma unroll
              for (int m = 0; m < 4; ++m) pv[ai][m] = *(const f32x4*)(ssq + (size_t)(u.pm * BM + ai * HALF + wr * 64 + m * 16 + fr) * 16 + fq * 4);
          __builtin_amdgcn_sched_barrier(0);
#pragma unroll
          for (int ai = 0; ai < 2; ++ai)
#pragma unroll
              for (int m = 0; m < 4; ++m) { const f32x4 p = pv[ai][m]; rsv[ai][m] = rsqrtf(xsum4((p[0] + p[1]) + (p[2] + p[3])) * (1.0f / 1024.0f) + EPS_); } }
        if (pn >= 3) {
#pragma unroll
            for (int ai = 0; ai < 2; ++ai)
#pragma unroll
                for (int m = 0; m < 4; ++m) {
                    const int row = u.pm * BM + ai * HALF + wr * 64 + m * 16 + fr; const float rs = rsv[ai][m];
                    f32x4 h[2];
#pragma unroll
                    for (int n = 0; n < 2; ++n)
#pragma unroll
                        for (int i = 0; i < 4; ++i) { const float uu = acc[ai][0][m][n][i] * rs, gg = acc[ai][1][m][n][i] * rs; h[n][i] = uu * __builtin_amdgcn_rcpf(1.0f + __expf(-gg)); }
                    *(u32x4*)(Hg + (size_t)row * 512 + (pn - 3) * 128 + wc * 32 + fq * 8) = pack8(h[0], h[1]);
                }
        } else if (pn < 2 || wc < 2) {
            const bool isq = pn < 2; const float* g = isq ? qg : kg; const float osc = isq ? QSCALE : 1.0f;
            bf16_t* base = isq ? Q + (pn * 4 + wc) * 64 : Kb + wc * 64; const int ld = isq ? 512 : 128;
            f32x4 gv[2][2];
#pragma unroll
            for (int bj = 0; bj < 2; ++bj)
#pragma unroll
                for (int n = 0; n < 2; ++n) gv[bj][n] = *(const f32x4*)(g + bj * 32 + fq * 8 + n * 4);
#pragma unroll
            for (int ai = 0; ai < 2; ++ai)
#pragma unroll
                for (int m = 0; m < 4; ++m) {
                    const int row = u.pm * BM + ai * HALF + wr * 64 + m * 16 + fr; const float rs = rsv[ai][m];
                    f32x4 v[2][2]; float ss = 0.f;
#pragma unroll
                    for (int bj = 0; bj < 2; ++bj)
#pragma unroll
                        for (int n = 0; n < 2; ++n) { v[bj][n] = acc[ai][bj][m][n] * rs; const f32x4 q = v[bj][n] * v[bj][n]; ss += (q[0] + q[1]) + (q[2] + q[3]); }
                    ss = xsum4(ss); const float r = rsqrtf(ss * (1.0f / 64.0f) + EPS_) * osc;
#pragma unroll
                    for (int bj = 0; bj < 2; ++bj) *(u32x4*)(base + (size_t)row * ld + bj * 32 + fq * 8) = pack8(v[bj][0] * gv[bj][0] * r, v[bj][1] * gv[bj][1] * r);
                }
        } else {
            const int kvh = wc - 2;
#pragma unroll
            for (int ai = 0; ai < 2; ++ai)
#pragma unroll
                for (int m = 0; m < 4; ++m) {
                    const int row = u.pm * BM + ai * HALF + wr * 64 + m * 16 + fr; const float rs = rsv[ai][m];
                    const int b = row / TT, t = row % TT;
#pragma unroll
                    for (int bj = 0; bj < 2; ++bj) { const int dc = bj * 4 + fq;
                        *(u32x4*)(Vg + ((size_t)((b * 2 + kvh) * 8 + dc) * TT + t) * 8) = pack8(acc[ai][bj][m][0] * rs, acc[ai][bj][m][1] * rs); }
                }
        }
    }
};
#ifndef RES_BF16
#define RES_BF16 1
#endif
struct EpiRes {
    static constexpr bool PERM = true, AFTER_DRAIN = false;
    const float* resid; float* xout; bf16_t* xb; float* ssq;
    __device__ __forceinline__ void init(f32x4 (&acc)[2][2][4][2], const Unit& u, int wr, int wc, int fr, int fq) const {
        if (resid) {
#pragma unroll
            for (int ai = 0; ai < 2; ++ai)
#pragma unroll
                for (int m = 0; m < 4; ++m) { const int row = u.pm * BM + ai * HALF + wr * 64 + m * 16 + fr;
#pragma unroll
                    for (int bj = 0; bj < 2; ++bj) { const size_t off = (size_t)row * 1024 + u.pn * BM + bj * HALF + wc * 32 + fq * 8;
                        acc[ai][bj][m][0] = *(const f32x4*)(resid + off); acc[ai][bj][m][1] = *(const f32x4*)(resid + off + 4); } }
        } else {
            u32x4 w[2][4][2];
#pragma unroll
            for (int ai = 0; ai < 2; ++ai)
#pragma unroll
                for (int m = 0; m < 4; ++m) { const int row = u.pm * BM + ai * HALF + wr * 64 + m * 16 + fr;
#pragma unroll
                    for (int bj = 0; bj < 2; ++bj) w[ai][m][bj] = *(const u32x4*)(xb + (size_t)row * 1024 + u.pn * BM + bj * HALF + wc * 32 + fq * 8); }
            __builtin_amdgcn_sched_barrier(0);
#pragma unroll
            for (int ai = 0; ai < 2; ++ai)
#pragma unroll
                for (int m = 0; m < 4; ++m)
#pragma unroll
                    for (int bj = 0; bj < 2; ++bj) { const u32x4 x = w[ai][m][bj];
                        acc[ai][bj][m][0] = (f32x4){__uint_as_float(x.x << 16), __uint_as_float(x.x & 0xffff0000u), __uint_as_float(x.y << 16), __uint_as_float(x.y & 0xffff0000u)};
                        acc[ai][bj][m][1] = (f32x4){__uint_as_float(x.z << 16), __uint_as_float(x.z & 0xffff0000u), __uint_as_float(x.w << 16), __uint_as_float(x.w & 0xffff0000u)}; }
        }
    }
    __device__ __forceinline__ void operator()(const f32x4 (&acc)[2][2][4][2], const Unit& u, int wr, int wc, int fr, int fq) const {
#pragma unroll
        for (int ai = 0; ai < 2; ++ai)
#pragma unroll
            for (int m = 0; m < 4; ++m) {
                const int row = u.pm * BM + ai * HALF + wr * 64 + m * 16 + fr; float ss = 0.f;
#pragma unroll
                for (int bj = 0; bj < 2; ++bj) { const size_t off = (size_t)row * 1024 + u.pn * BM + bj * HALF + wc * 32 + fq * 8;
                    const f32x4 v0 = acc[ai][bj][m][0], v1 = acc[ai][bj][m][1];
                    if (xout) { __builtin_nontemporal_store(v0, (f32x4*)(xout + off)); __builtin_nontemporal_store(v1, (f32x4*)(xout + off + 4)); }
                    *(u32x4*)(xb + off) = pack8(v0, v1);
                    const f32x4 q0 = v0 * v0, q1 = v1 * v1; ss += ((q0[0] + q0[1]) + (q0[2] + q0[3])) + ((q1[0] + q1[1]) + (q1[2] + q1[3])); }
                ss = xsum4(ss);
                if (fq == 0) ssq[(size_t)row * 16 + u.pn * 4 + wc] = ss;
            }
    }
};
struct EpiUp {
    static constexpr bool PERM = true, AFTER_DRAIN = false;
    const float* ssq; bf16_t* Hid;
    __device__ __forceinline__ void init(f32x4 (&acc)[2][2][4][2], const Unit&, int, int, int, int) const { zero_acc(acc); }
    __device__ __forceinline__ void operator()(const f32x4 (&acc)[2][2][4][2], const Unit& u, int wr, int wc, int fr, int fq) const {
        float rsv[2][4];
        { f32x4 pv[2][4];
#pragma unroll
          for (int ai = 0; ai < 2; ++ai)
#pragma unroll
              for (int m = 0; m < 4; ++m) pv[ai][m] = *(const f32x4*)(ssq + (size_t)(u.pm * BM + ai * HALF + wr * 64 + m * 16 + fr) * 16 + fq * 4);
          __builtin_amdgcn_sched_barrier(0);
#pragma unroll
          for (int ai = 0; ai < 2; ++ai)
#pragma unroll
              for (int m = 0; m < 4; ++m) { const f32x4 p = pv[ai][m]; rsv[ai][m] = rsqrtf(xsum4((p[0] + p[1]) + (p[2] + p[3])) * (1.0f / 1024.0f) + EPS_); } }
#pragma unroll
        for (int ai = 0; ai < 2; ++ai)
#pragma unroll
            for (int m = 0; m < 4; ++m) {
                const int row = u.pm * BM + ai * HALF + wr * 64 + m * 16 + fr; const float rs = rsv[ai][m];
#pragma unroll
                for (int bj = 0; bj < 2; ++bj) { f32x4 v0 = acc[ai][bj][m][0] * rs, v1 = acc[ai][bj][m][1] * rs;
#pragma unroll
                    for (int i = 0; i < 4; ++i) { const float a = fmaxf(v0[i], 0.f), b = fmaxf(v1[i], 0.f); v0[i] = a * a; v1[i] = b * b; }
                    *(u32x4*)(Hid + (size_t)row * 4096 + u.pn * BM + bj * HALF + wc * 32 + fq * 8) = pack8(v0, v1); }

            }
    }
};
template <class Epi, class Sched, bool ALIGN_EPI = false, bool SP2 = false, bool ZZ = false>
__device__ __forceinline__ void gemm_phase(PG8_LAS unsigned char* lds, const Gemm g, const Sched& S, const Epi& E) {
    int tid_ = threadIdx.x; asm volatile("" : "+v"(tid_));
    const int tid = tid_, wid = __builtin_amdgcn_readfirstlane(tid >> 6), lane = tid & 63, wr = wid >> 2, wc = wid & 3, fr = lane & 15, fq = lane >> 4;
    const int K = g.K, nt = K / BK;
    unsigned voffA[2], voffB[2];
#pragma unroll
    for (int i = 0; i < 2; ++i) { int R, C; stage_rc(tid * 16 + i * 8192, R, C); const int Rb = Epi::PERM ? ((R & ~31) + perm32(R & 31)) : R;
        voffA[i] = (unsigned)(R * K + C) * 2u; voffB[i] = (unsigned)(Rb * K + C) * 2u; }
    const long kstep = (long)(BK * 2);
    const size_t hstep = (size_t)HALF * K * 2;
    const size_t tstep = 2 * hstep;
    const unsigned ldsw = (unsigned)wid * 1024u;
    const int aoff = lds_byte(wr * 64 + fr, fq * 8), boff = lds_byte(wc * 32 + fr, fq * 8);
#define PG8_SA(b, h) (((b) * 2 + (h)) * HTB)
#define PG8_SB(b, h) ((4 + (b) * 2 + (h)) * HTB)
#define PG8_STAGE(bufoff, gbase, voff) do { _Pragma("unroll") for (int _i = 0; _i < 2; ++_i) \
        __builtin_amdgcn_global_load_lds((const unsigned*)((const char*)(gbase) + (voff)[_i]), (PG8_LAS unsigned*)(lds + (bufoff) + ldsw + _i * 8192), 16, 0, 0); } while (0)
#define PG8_LDA(dst, b, h) do { _Pragma("unroll") for (int m = 0; m < 4; ++m) _Pragma("unroll") for (int k = 0; k < 2; ++k) dst[m][k] = *(const PG8_LAS bf16x8*)(lds + PG8_SA(b, h) + aoff + m * 2048 + k * 1024); } while (0)
#define PG8_LDB(dst, b, h) do { _Pragma("unroll") for (int n = 0; n < 2; ++n) _Pragma("unroll") for (int k = 0; k < 2; ++k) dst[n][k] = *(const PG8_LAS bf16x8*)(lds + PG8_SB(b, h) + boff + n * 2048 + k * 1024); } while (0)
#define PG8_MMA(ai, bj, At, Bt) do { __builtin_amdgcn_s_setprio(1); _Pragma("unroll") for (int m = 0; m < 4; ++m) _Pragma("unroll") for (int n = 0; n < 2; ++n) _Pragma("unroll") for (int k = 0; k < 2; ++k) \
        acc[ai][bj][m][n] = __builtin_amdgcn_mfma_f32_16x16x32_bf16(Bt[n][k], At[m][k], acc[ai][bj][m][n], 0, 0, 0); __builtin_amdgcn_s_setprio(0); } while (0)
#define PG8_WAIT_V(n) asm volatile("s_waitcnt vmcnt(" #n ")" ::: "memory")
#define PG8_WAIT_L(n) asm volatile("s_waitcnt lgkmcnt(" #n ")" ::: "memory")
#define PG8_BAR __builtin_amdgcn_s_barrier()
#define PG8_SCHED __builtin_amdgcn_sched_barrier(0)
    Unit cur, nxt; int ui = 0;
    if (!S.next(0, cur)) return;
    f32x4 acc[2][2][4][2];
    E.init(acc, cur, wr, wc, fr, fq);
    bf16x8 At[4][2], B0[2][2], B1[2][2];
    const char* cA = (const char*)g.A + (size_t)cur.pm * tstep; const char* cB = (const char*)g.Bt + (size_t)cur.pn * tstep;
    long ks = kstep, ksn = kstep;
    S.a_ready(cur);
    if constexpr (SP2) {
        PG8_STAGE(PG8_SB(0, 0), cB, voffB); PG8_STAGE(PG8_SB(0, 1), cB + hstep, voffB); PG8_STAGE(PG8_SA(0, 0), cA, voffA); PG8_STAGE(PG8_SA(0, 1), cA + hstep, voffA);
        if (wr == 1) PG8_BAR;
        PG8_WAIT_V(2); PG8_BAR;
        PG8_STAGE(PG8_SB(1, 0), cB + kstep, voffB); PG8_STAGE(PG8_SA(1, 0), cA + kstep, voffA); PG8_STAGE(PG8_SB(1, 1), cB + hstep + kstep, voffB);
        PG8_WAIT_V(6); PG8_BAR;
    } else {
        PG8_STAGE(PG8_SB(0, 0), cB, voffB); PG8_STAGE(PG8_SA(0, 0), cA, voffA); PG8_STAGE(PG8_SB(0, 1), cB + hstep, voffB); PG8_STAGE(PG8_SA(0, 1), cA + hstep, voffA);
        if (wr == 1) PG8_BAR;
        PG8_WAIT_V(4); PG8_BAR;
        PG8_STAGE(PG8_SB(1, 0), cB + kstep, voffB); PG8_STAGE(PG8_SA(1, 0), cA + kstep, voffA); PG8_STAGE(PG8_SB(1, 1), cB + hstep + kstep, voffB);
        PG8_WAIT_V(6); PG8_BAR;
    }
    for (;;) {
        const bool has_next = S.next(ui + 1, nxt);
        const bool nrev = ZZ && has_next && (((ui + 1) & 1) != 0); const long noff = nrev ? (long)(nt - 1) * kstep : 0l;
        ksn = has_next ? (nrev ? -kstep : kstep) : ks;
        const char* nA = has_next ? (const char*)g.A + (size_t)nxt.pm * tstep + noff : cA; const char* nB = has_next ? (const char*)g.Bt + (size_t)nxt.pn * tstep + noff : cB;
        for (int t = 0; t < nt; t += 2) {
            const bool last = (t == nt - 2);
            const char* a1 = cA + (long)(t + 1) * ks;
            const char* a2 = last ? nA : cA + (long)(t + 2) * ks; const char* b2 = last ? nB : cB + (long)(t + 2) * ks;
            const long k3 = last ? ksn : ks; const char* a3 = a2 + k3; const char* b3 = b2 + k3;
            if (last && has_next) S.a_ready(nxt);
            if constexpr (SP2) {
            PG8_LDB(B0, 0, 0); PG8_LDB(B1, 0, 1); PG8_SCHED; PG8_LDA(At, 0, 0); PG8_STAGE(PG8_SA(1, 1), a1 + hstep, voffA);
            PG8_WAIT_V(8); PG8_WAIT_L(0); PG8_BAR; PG8_MMA(0, 0, At, B0); PG8_MMA(0, 1, At, B1); PG8_BAR; PG8_SCHED;
            PG8_LDA(At, 0, 1); PG8_STAGE(PG8_SB(0, 0), b2, voffB); PG8_STAGE(PG8_SB(0, 1), b2 + hstep, voffB); PG8_STAGE(PG8_SA(0, 0), a2, voffA);
            PG8_WAIT_V(8); PG8_WAIT_L(0); PG8_BAR; PG8_MMA(1, 0, At, B0); PG8_MMA(1, 1, At, B1); PG8_BAR; PG8_SCHED;
            PG8_LDB(B0, 1, 0); PG8_LDB(B1, 1, 1); PG8_SCHED; PG8_LDA(At, 1, 0); PG8_STAGE(PG8_SA(0, 1), a2 + hstep, voffA);
            PG8_WAIT_V(8); PG8_WAIT_L(0); PG8_BAR; PG8_MMA(0, 0, At, B0); PG8_MMA(0, 1, At, B1); PG8_BAR; PG8_SCHED;
            PG8_LDA(At, 1, 1); PG8_STAGE(PG8_SB(1, 0), b3, voffB); PG8_STAGE(PG8_SB(1, 1), b3 + hstep, voffB); PG8_STAGE(PG8_SA(1, 0), a3, voffA);
            PG8_WAIT_V(8); PG8_WAIT_L(0); PG8_BAR; PG8_MMA(1, 0, At, B0); PG8_MMA(1, 1, At, B1); PG8_BAR; PG8_SCHED;
            } else {
            PG8_LDB(B0, 0, 0); PG8_SCHED; PG8_LDA(At, 0, 0); PG8_STAGE(PG8_SA(1, 1), a1 + hstep, voffA);
            PG8_WAIT_L(8); PG8_BAR; PG8_WAIT_L(0); PG8_MMA(0, 0, At, B0); PG8_BAR; PG8_SCHED;
            PG8_LDB(B1, 0, 1); PG8_STAGE(PG8_SB(0, 0), b2, voffB);
            PG8_BAR; PG8_WAIT_L(0); PG8_MMA(0, 1, At, B1); PG8_BAR;
            PG8_LDA(At, 0, 1); PG8_STAGE(PG8_SA(0, 0), a2, voffA);
            PG8_BAR; PG8_WAIT_L(0); PG8_MMA(1, 0, At, B0); PG8_BAR; PG8_SCHED;
            PG8_STAGE(PG8_SB(0, 1), b2 + hstep, voffB);
            PG8_WAIT_V(6); PG8_BAR; PG8_MMA(1, 1, At, B1); PG8_BAR;
            PG8_LDB(B0, 1, 0); PG8_SCHED; PG8_LDA(At, 1, 0); PG8_STAGE(PG8_SA(0, 1), a2 + hstep, voffA);
            PG8_WAIT_L(8); PG8_BAR; PG8_WAIT_L(0); PG8_MMA(0, 0, At, B0); PG8_BAR; PG8_SCHED;
            PG8_LDB(B1, 1, 1); PG8_STAGE(PG8_SB(1, 0), b3, voffB);
            PG8_BAR; PG8_WAIT_L(0); PG8_MMA(0, 1, At, B1); PG8_BAR;
            PG8_LDA(At, 1, 1); PG8_STAGE(PG8_SA(1, 0), a3, voffA);
            PG8_BAR; PG8_WAIT_L(0); PG8_MMA(1, 0, At, B0); PG8_BAR; PG8_SCHED;
            PG8_STAGE(PG8_SB(1, 1), b3 + hstep, voffB);
            PG8_WAIT_V(6); PG8_BAR; PG8_MMA(1, 1, At, B1); PG8_BAR;
            }
        }
        if constexpr (ALIGN_EPI) { if (wr == 0) PG8_BAR; }
        if constexpr (!Epi::AFTER_DRAIN) { E(acc, cur, wr, wc, fr, fq); S.done(cur); }
        if (!has_next) break;
        E.init(acc, nxt, wr, wc, fr, fq);
        cur = nxt; cA = nA; cB = nB; ks = ksn; ++ui;
        if constexpr (ALIGN_EPI) { if (wr == 1) PG8_BAR; }
    }
    PG8_WAIT_V(0);
    if constexpr (!ALIGN_EPI) { if (wr == 0) PG8_BAR; }
    PG8_BAR;
    if constexpr (Epi::AFTER_DRAIN) { E.fused(acc, cur, wr, wc, fr, fq, lds, wid, lane); S.done(cur); }
#undef PG8_SA
#undef PG8_SB
#undef PG8_STAGE
#undef PG8_LDA
#undef PG8_LDB
#undef PG8_MMA
#undef PG8_WAIT_V
#undef PG8_WAIT_L
#undef PG8_BAR
#undef PG8_SCHED
}
}
#define LAS __attribute__((address_space(3)))
typedef unsigned short bf16;
typedef unsigned u32x4 __attribute__((ext_vector_type(4)));
typedef unsigned u32x2 __attribute__((ext_vector_type(2)));
typedef float f32x4 __attribute__((ext_vector_type(4)));
typedef float f32x2 __attribute__((ext_vector_type(2)));
typedef short bf16x8 __attribute__((ext_vector_type(8)));
typedef float f32x16 __attribute__((ext_vector_type(16)));

#define XB_TMO      128
#define XB_XCNT(j)  (256  + 64 * (j))
#define XB_XSUB(j)  (1280 + 64 * (j))
#define XB_XGEN(j)  (2304 + 64 * (j))
#define XB_TOP      3328
#define XB_TOPGEN   3392
#define XCD_BAR_WORDS 3456
#define XB_SPIN_CAP (1u << 18)

__device__ __forceinline__ unsigned xb_ld(unsigned* p)              { return __hip_atomic_load(p, __ATOMIC_RELAXED, __HIP_MEMORY_SCOPE_AGENT); }
__device__ __forceinline__ unsigned xb_add(unsigned* p, unsigned v) { return __hip_atomic_fetch_add(p, v, __ATOMIC_RELAXED, __HIP_MEMORY_SCOPE_AGENT); }
__device__ __forceinline__ unsigned xb_xcc_id() { return (unsigned)__builtin_amdgcn_s_getreg((3 << 11) | 20) & 0xFu; }
#define XB_SPIN(cond, bar) do { unsigned _sp = 0; while (cond) { __builtin_amdgcn_s_sleep(1); \
    if ((++_sp & 255u) == 0u) { if (xb_ld(&(bar)[XB_TMO])) break; if (_sp > XB_SPIN_CAP) { atomicAdd(&(bar)[XB_TMO], 1u); break; } } } } while (0)

struct XcdBarrier {
    unsigned* bar; unsigned x;
    volatile LAS unsigned* st;
};

__device__ __forceinline__ XcdBarrier xcd_barrier_post(unsigned* bar, volatile LAS unsigned* st) {
    XcdBarrier b; b.bar = bar; b.x = xb_xcc_id(); b.st = st;
    if (threadIdx.x == 0) (void)xb_add(&bar[XB_XCNT(b.x)], 1u);
    return b;
}
__device__ __forceinline__ void xcd_barrier_complete(unsigned* bar, unsigned x, unsigned& nloc, unsigned& nx) {
    const unsigned G = gridDim.x * gridDim.y * gridDim.z;
    unsigned sum, cnt, mine, sp = 0u;
    for (;;) {
        sum = 0u; cnt = 0u; mine = 0u;
#pragma unroll
        for (unsigned j = 0; j < 16; ++j) { const unsigned c = xb_ld(&bar[XB_XCNT(j)]); sum += c; cnt += (c > 0u) ? 1u : 0u; mine = (j == x) ? c : mine; }
        if (sum == G) break;
        __builtin_amdgcn_s_sleep(1);
        if ((++sp & 255u) == 0u) { if (xb_ld(&bar[XB_TMO])) break; if (sp > XB_SPIN_CAP) { atomicAdd(&bar[XB_TMO], 1u); break; } }
    }
    nloc = mine > 0u ? mine : 1u; nx = cnt > 0u ? cnt : 1u;
}

__device__ __forceinline__ void xcd_barrier(const XcdBarrier& b) {
    asm volatile("s_waitcnt vmcnt(0)" ::: "memory");
    __syncthreads();
    if (threadIdx.x == 0) {
        unsigned* bar = b.bar;
        __builtin_amdgcn_s_waitcnt(0);
        unsigned nloc = b.st[0], nx = b.st[1];
        if (nloc == 0u) { xcd_barrier_complete(bar, b.x, nloc, nx); b.st[0] = nloc; b.st[1] = nx; }
        const unsigned old = xb_add(&bar[XB_XSUB(b.x)], 1u);
        const unsigned gen = old / nloc;
        if (old + 1u == (gen + 1u) * nloc) {
            __builtin_amdgcn_fence(__ATOMIC_RELEASE, "agent");
            asm volatile("s_waitcnt vmcnt(0)" ::: "memory");
            const unsigned og = xb_add(&bar[XB_TOP], 1u);
            const unsigned tg = og / nx;
            if (og + 1u == (tg + 1u) * nx) xb_add(&bar[XB_TOPGEN], 1u);
            else XB_SPIN(xb_ld(&bar[XB_TOPGEN]) == tg, bar);
            __builtin_amdgcn_fence(__ATOMIC_ACQUIRE, "agent");
            xb_add(&bar[XB_XGEN(b.x)], 1u);
            asm volatile("s_waitcnt vmcnt(0)" ::: "memory");
        } else {
            XB_SPIN(xb_ld(&bar[XB_XGEN(b.x)]) == gen, bar);
            __builtin_amdgcn_fence(__ATOMIC_ACQUIRE, "agent");
            asm volatile("s_waitcnt vmcnt(0)" ::: "memory");
        }
    }
    __syncthreads();
}

constexpr int NB = 4, T = 8192, D = 1024, M = NB * T, DEPTH = 4, INW = 1792, FF = 4096;
constexpr float EPS = 1e-6f, LOG2E = 1.4426950408889634f;
constexpr size_t MiB = 1u << 20;
constexpr size_t WS_WIN = 1 * MiB, WS_WOUT = 16 * MiB, WS_WUP = 24 * MiB, WS_WDN = 56 * MiB, WS_XB = 88 * MiB, WS_SSQ = 152 * MiB;
constexpr size_t WS_Q = 154 * MiB, WS_K = 186 * MiB, WS_V = 194 * MiB, WS_HG = 202 * MiB, WS_MIX = 234 * MiB;
constexpr size_t WS_HID = 154 * MiB, WS_END = 410 * MiB;
constexpr size_t SZ_WIN = (size_t)INW * D * 2, SZ_WOUT = (size_t)D * D * 2, SZ_WUP = (size_t)FF * D * 2, SZ_WDN = (size_t)D * FF * 2;
static_assert(WS_WIN + DEPTH * SZ_WIN <= WS_WOUT && WS_WOUT + DEPTH * SZ_WOUT <= WS_WUP && WS_WUP + DEPTH * SZ_WUP <= WS_WDN && WS_WDN + DEPTH * SZ_WDN <= WS_XB, "weights map");
static_assert(WS_XB + (size_t)M * D * 2 <= WS_SSQ && WS_SSQ + (size_t)M * 16 * 4 <= WS_Q && WS_MIX + (size_t)M * D * 2 <= WS_END && WS_HID + (size_t)M * FF * 2 <= WS_END, "activation map");
constexpr int KP = 144, VP = 528;
constexpr int L_K = 0, L_V = 2 * 256 * KP, L_BIAS = L_V + 2 * 64 * VP, L_SSQ = L_BIAS + 8 * 192 * 4, L_END = L_SSQ + 2 * 8 * 32 * 4;
constexpr int LDS_BYTES = 155648;
constexpr int MISC_OFF = LDS_BYTES - 256;
constexpr size_t WS_CTL = 0, CTL_ZERO_BYTES = 16384;
static_assert(L_END <= MISC_OFF && pg8::STAGE_BYTES <= MISC_OFF && XCD_BAR_WORDS * 4 <= (int)CTL_ZERO_BYTES, "LDS map");

__device__ __forceinline__ int tid_opaque() { int t = threadIdx.x; asm volatile("" : "+v"(t)); return t; }
template <int CTRL> __device__ __forceinline__ float dppf(float v) { return __builtin_bit_cast(float, __builtin_amdgcn_update_dpp(0, __builtin_bit_cast(int, v), CTRL, 0xf, 0xf, false)); }
__device__ __forceinline__ float wave_sum(float v) {
    v += dppf<0xB1>(v);
    v += dppf<0x4E>(v);
    v += dppf<0x141>(v);
    v += dppf<0x140>(v);
    const int vi = __builtin_bit_cast(int, v);
    const float r0 = __builtin_bit_cast(float, __builtin_amdgcn_readlane(vi, 0)), r1 = __builtin_bit_cast(float, __builtin_amdgcn_readlane(vi, 16));
    const float r2 = __builtin_bit_cast(float, __builtin_amdgcn_readlane(vi, 32)), r3 = __builtin_bit_cast(float, __builtin_amdgcn_readlane(vi, 48));
    return (r0 + r1) + (r2 + r3);
}
__device__ __forceinline__ unsigned pk2(float lo, float hi) { return pg8::cvt_pk_bf16(lo, hi); }

__device__ __forceinline__ int in_col_map(int n0) {
    if (n0 < 768) { const int pn = n0 >> 8, l = n0 & 255; return (pn << 8) + ((l >> 5) & 1) * 128 + (l >> 6) * 32; }
    if (n0 < 1280) { const int ch = n0 - 768; return ((3 + (ch >> 7)) << 8) + (ch & 127); }
    const int ch = n0 - 1280; return ((3 + (ch >> 7)) << 8) + 128 + (ch & 127);
}
__device__ __forceinline__ void transpose_item(const float* W, int K, int N, bf16* WT, const float* g0, const float* g1, bool inmap, LAS float* scr, int item, int lane, bool stream) {
    const int nblk = N / 32, kb = item / nblk, nb = item % nblk, k0 = 64 * kb, n0 = 32 * nb;
    float wv[32];
#pragma unroll
    for (int i = 0; i < 32; ++i) wv[i] = __builtin_nontemporal_load(W + (size_t)(k0 + 2 * i + (lane >> 5)) * N + n0 + (lane & 31));
#pragma unroll
    for (int i = 0; i < 32; ++i) { const int kk = 2 * i + (lane >> 5), k = k0 + kk; const float g = g0 ? (k < 512 ? g0[k] : g1[k - 512]) : 1.0f;
        scr[kk * 33 + (lane & 31)] = wv[i] * g; }
    asm volatile("s_waitcnt lgkmcnt(0)" ::: "memory");
    const int c = lane & 7, d0 = inmap ? in_col_map(n0) : n0;
    float tv[4][8];
#pragma unroll
    for (int j = 0; j < 4; ++j)
#pragma unroll
        for (int i = 0; i < 8; ++i) tv[j][i] = scr[(8 * c + i) * 33 + (lane >> 3) + 8 * j];
    __builtin_amdgcn_sched_barrier(0);
#pragma unroll
    for (int j = 0; j < 4; ++j) { const int n = (lane >> 3) + 8 * j;
        u32x4 o; o.x = pk2(tv[j][0], tv[j][1]); o.y = pk2(tv[j][2], tv[j][3]); o.z = pk2(tv[j][4], tv[j][5]); o.w = pk2(tv[j][6], tv[j][7]);
        if (stream) __builtin_nontemporal_store(o, (u32x4*)(WT + (size_t)(d0 + n) * K + k0 + 8 * c)); else *(u32x4*)(WT + (size_t)(d0 + n) * K + k0 + 8 * c) = o; }
    asm volatile("s_waitcnt lgkmcnt(0)" ::: "memory");
}

struct Args {
    const float* x; const float* rel_bias; const float* norm_mix_g; const float* w_in; const float* q_norm_g; const float* k_norm_g; const float* sinks;
    const float* conv_w; const float* conv_b; const float* conv_ln_g; const float* conv_ln_b; const float* attn_out_g; const float* conv_out_g; const float* w_out;
    const float* norm_mlp_g; const float* w_mlp_up; const float* w_mlp_down;
    float* out; unsigned char* ws; int ph_lo, ph_hi;
};

__device__ __forceinline__ void convert_layer(const Args& a, LAS unsigned char* lds, int l, int gw, int NGW) {
    const int tid = tid_opaque(), lane = tid & 63, wave = tid >> 6;
    LAS float* scr = (LAS float*)(lds + wave * 16384);
    constexpr int I_IN = (D / 64) * (INW / 32), I_OUT = (D / 64) * (D / 32), I_UP = (D / 64) * (FF / 32), I_DN = (FF / 64) * (D / 32), I_L = I_IN + I_OUT + I_UP + I_DN;
    for (int it = gw; it < I_L; it += NGW) {
        int r = it;
        if (r < I_IN) { transpose_item(a.w_in + (size_t)l * D * INW, D, INW, (bf16*)(a.ws + WS_WIN + l * SZ_WIN), a.norm_mix_g + l * D, a.norm_mix_g + l * D + 512, true, scr, r, lane, l > 0); continue; } r -= I_IN;
        if (r < I_OUT) { transpose_item(a.w_out + (size_t)l * D * D, D, D, (bf16*)(a.ws + WS_WOUT + l * SZ_WOUT), a.attn_out_g + l * 512, a.conv_out_g + l * 512, false, scr, r, lane, l > 0); continue; } r -= I_OUT;
        if (r < I_UP) { transpose_item(a.w_mlp_up + (size_t)l * D * FF, D, FF, (bf16*)(a.ws + WS_WUP + l * SZ_WUP), a.norm_mlp_g + l * D, a.norm_mlp_g + l * D + 512, false, scr, r, lane, l > 0); continue; } r -= I_UP;
        transpose_item(a.w_mlp_down + (size_t)l * FF * D, FF, D, (bf16*)(a.ws + WS_WDN + l * SZ_WDN), nullptr, nullptr, false, scr, r, lane, l > 0);
    }
}
__device__ __forceinline__ void prologue(const Args& a, LAS unsigned char* lds, int vcu, int G) {
    const int tid = tid_opaque(), lane = tid & 63, wave = tid >> 6;
    const int gw = vcu * 8 + wave, NGW = G * 8;
    convert_layer(a, lds, 0, gw, NGW);
    bf16* xb = (bf16*)(a.ws + WS_XB); float* ssq = (float*)(a.ws + WS_SSQ);
    const int rpb = M / G, rbase = vcu * rpb;
    for (int m0 = rbase + wave * 4; m0 < rbase + rpb; m0 += 32) {
        f32x4 v[4][4]; float s[4];
#pragma unroll
        for (int q = 0; q < 4; ++q) { const f32x4* xr = (const f32x4*)(a.x + (size_t)(m0 + q) * D) + lane;
#pragma unroll
            for (int j = 0; j < 4; ++j) v[q][j] = __builtin_nontemporal_load(xr + 64 * j); }
#pragma unroll
        for (int q = 0; q < 4; ++q) { float t = 0.f;
#pragma unroll
            for (int j = 0; j < 4; ++j) t += (v[q][j][0] * v[q][j][0] + v[q][j][1] * v[q][j][1]) + (v[q][j][2] * v[q][j][2] + v[q][j][3] * v[q][j][3]);
            s[q] = wave_sum(t); }
#pragma unroll
        for (int q = 0; q < 4; ++q) { u32x2* o8 = (u32x2*)(xb + (size_t)(m0 + q) * D) + lane;
#pragma unroll
            for (int j = 0; j < 4; ++j) { u32x2 w; w.x = pk2(v[q][j][0], v[q][j][1]); w.y = pk2(v[q][j][2], v[q][j][3]); o8[64 * j] = w; } }
        { const int q = lane >> 4, c = lane & 15; const float sq = q == 0 ? s[0] : q == 1 ? s[1] : q == 2 ? s[2] : s[3]; ssq[(size_t)(m0 + q) * 16 + c] = c == 0 ? sq : 0.f; }
    }
}

__device__ __forceinline__ void attn_bias_table(LAS unsigned char* lds, const float* rel_bias) {
    LAS float* bt = (LAS float*)(lds + L_BIAS);
    for (int i = tid_opaque(); i < 8 * 192; i += 512) { const int h = i / 192, dist = 159 - i % 192; float v = 0.f;
        if (dist >= 0 && dist < 128) { int bk = dist; if (dist >= 16) { bk = 16 + (int)(__log2f((float)dist * 0.0625f) * (16.0f / 3.0f)); bk = bk < 31 ? bk : 31; } v = rel_bias[bk * 8 + h] * LOG2E; }
        bt[i] = v; }
}
__device__ __forceinline__ void attn_stage(LAS unsigned char* lds, int b, int qb, const bf16* Kb, const bf16* Vg) {
    const int tid = tid_opaque(), tok0 = qb * 128 - 128;
#pragma unroll
    for (int it = 0; it < 8; ++it) { const int c = it * 512 + tid, kb = c >> 4, sub = c & 15, tok = tok0 + kb;
        u32x4 v = (u32x4){0u, 0u, 0u, 0u}; if (tok >= 0) v = *(const u32x4*)(Kb + ((size_t)b * T + tok) * 128 + sub * 8);
        *(LAS u32x4*)(lds + L_K + (sub >> 3) * 256 * KP + kb * KP + (sub & 7) * 16) = v; }
#pragma unroll
    for (int it = 0; it < 8; ++it) { const int c = it * 512 + tid, kb = c & 255, grp = c >> 8, tok = tok0 + kb;
        u32x4 v = (u32x4){0u, 0u, 0u, 0u}; if (tok >= 0) v = *(const u32x4*)(Vg + ((size_t)(b * 16 + grp) * T + tok) * 8);
        const int pos = (kb & ~12) | ((kb & 4) << 1) | ((kb & 8) >> 1);
        LAS unsigned short* d = (LAS unsigned short*)(lds + L_V + (grp >> 3) * 64 * VP + (grp & 7) * 8 * VP + pos * 2);
        d[0 * (VP / 2)] = (unsigned short)(v.x & 0xffffu); d[1 * (VP / 2)] = (unsigned short)(v.x >> 16);
        d[2 * (VP / 2)] = (unsigned short)(v.y & 0xffffu); d[3 * (VP / 2)] = (unsigned short)(v.y >> 16);
        d[4 * (VP / 2)] = (unsigned short)(v.z & 0xffffu); d[5 * (VP / 2)] = (unsigned short)(v.z >> 16);
        d[6 * (VP / 2)] = (unsigned short)(v.w & 0xffffu); d[7 * (VP / 2)] = (unsigned short)(v.w >> 16); }
}
__device__ __forceinline__ void attn_compute(LAS unsigned char* lds, int b, int qb, const bf16* Q, bf16* mix, const float* sinks_l) {
    const int tid = tid_opaque(), lane = tid & 63, r32 = lane & 31, hi = lane >> 5;
    const int h = __builtin_amdgcn_readfirstlane(tid >> 6), kvh = h >> 2;
    const LAS float* bR = (const LAS float*)(lds + L_BIAS) + h * 192 + 31 - (r32 - 4 * hi);
    const LAS unsigned char* Kl = lds + L_K + kvh * 256 * KP + r32 * KP + hi * 16;
    const LAS unsigned char* Vl = lds + L_V + kvh * 64 * VP + r32 * VP + hi * 16;
    const size_t rowbase = (size_t)b * T + (size_t)qb * 128;
    const int jmin = (qb == 0) ? 4 : 0;
    const float sink2 = sinks_l[h] * LOG2E;
    const bf16* qp = Q + (rowbase + r32) * 512 + h * 64 + hi * 8;
    bf16x8 qn[4];
#pragma unroll
    for (int ds = 0; ds < 4; ++ds) qn[ds] = *(const bf16x8*)(qp + ds * 16);
#pragma unroll 1
    for (int rb = 0; rb < 4; ++rb) {
        bf16x8 qf[4];
#pragma unroll
        for (int ds = 0; ds < 4; ++ds) qf[ds] = qn[ds];
        if (rb < 3) {
#pragma unroll
            for (int ds = 0; ds < 4; ++ds) qn[ds] = *(const bf16x8*)(qp + (size_t)(rb + 1) * 32 * 512 + ds * 16);
        }
        f32x16 s[5];
        bf16x8 kf[2][4];
#pragma unroll
        for (int ds = 0; ds < 4; ++ds) kf[0][ds] = *(const LAS bf16x8*)(Kl + (32 * rb) * KP + ds * 32);
#pragma unroll
        for (int j = 0; j < 5; ++j) {
            if (j < 4) {
#pragma unroll
                for (int ds = 0; ds < 4; ++ds) kf[(j + 1) & 1][ds] = *(const LAS bf16x8*)(Kl + (32 * (rb + j + 1)) * KP + ds * 32);
            }
            __builtin_amdgcn_sched_barrier(0);
            const float s0 = ((rb + j) >= jmin) ? 0.f : -1e30f;
#pragma unroll
            for (int r = 0; r < 16; ++r) s[j][r] = s0;
#pragma unroll
            for (int ds = 0; ds < 4; ++ds) s[j] = __builtin_amdgcn_mfma_f32_32x32x16_bf16(kf[j & 1][ds], qf[ds], s[j], 0, 0, 0);
            __builtin_amdgcn_sched_barrier(0);
        }
        float mx = sink2;
        const int tq = r32 - 4 * hi;
        f32x2 sv[5][8];
        f32x2 bz[2][8];
#pragma unroll
        for (int r2 = 0; r2 < 8; ++r2) { const int kc = ((2 * r2) & 3) + 8 * ((2 * r2) >> 2); bz[0][r2] = (f32x2){bR[kc], bR[kc + 1]}; }
#pragma unroll
        for (int j = 0; j < 5; ++j) {
            if (j < 4) {
#pragma unroll
                for (int r2 = 0; r2 < 8; ++r2) { const int kc = ((2 * r2) & 3) + 8 * ((2 * r2) >> 2); bz[(j + 1) & 1][r2] = (f32x2){bR[32 * (j + 1) + kc], bR[32 * (j + 1) + kc + 1]}; }
            }
            __builtin_amdgcn_sched_barrier(0);
#pragma unroll
            for (int r2 = 0; r2 < 8; ++r2) { const int r = 2 * r2, kc = (r & 3) + 8 * (r >> 2);
                f32x2 v = (f32x2){s[j][r], s[j][r + 1]} + bz[j & 1][r2];
                if (j == 0) v += (f32x2){(kc > tq) ? 0.f : -1e30f, (kc + 1 > tq) ? 0.f : -1e30f};
                if (j == 4) v += (f32x2){(kc <= tq) ? 0.f : -1e30f, (kc + 1 <= tq) ? 0.f : -1e30f};
                sv[j][r2] = v; mx = fmaxf(mx, fmaxf(v[0], v[1])); }
            __builtin_amdgcn_sched_barrier(0);
        }
        { const auto sw = __builtin_amdgcn_permlane32_swap(__float_as_uint(mx), __float_as_uint(mx), false, false); mx = fmaxf(__uint_as_float(sw[0]), __uint_as_float(sw[1])); }
        f32x2 l2 = (f32x2){0.f, 0.f}; const f32x2 mx2 = (f32x2){mx, mx};
        f32x16 o[2];
#pragma unroll
        for (int r = 0; r < 16; ++r) { o[0][r] = 0.f; o[1][r] = 0.f; }
        bf16x8 vf[2][4];
#pragma unroll
        for (int q = 0; q < 4; ++q) vf[0][q] = *(const LAS bf16x8*)(Vl + (q & 1) * 32 * VP + (32 * rb + 16 * (q >> 1)) * 2);
#pragma unroll
        for (int j = 0; j < 5; ++j) {
            if (j < 4) {
#pragma unroll
                for (int q = 0; q < 4; ++q) vf[(j + 1) & 1][q] = *(const LAS bf16x8*)(Vl + (q & 1) * 32 * VP + (32 * (rb + j + 1) + 16 * (q >> 1)) * 2);
            }
            __builtin_amdgcn_sched_barrier(0);
#pragma unroll
            for (int r2 = 0; r2 < 8; ++r2) { const f32x2 d = sv[j][r2] - mx2; f32x2 p; p[0] = __builtin_amdgcn_exp2f(d[0]); p[1] = __builtin_amdgcn_exp2f(d[1]); sv[j][r2] = p; l2 += p; }
#pragma unroll
            for (int sh = 0; sh < 2; ++sh) {
                u32x4 pw; pw.x = pk2(sv[j][4 * sh + 0][0], sv[j][4 * sh + 0][1]); pw.y = pk2(sv[j][4 * sh + 1][0], sv[j][4 * sh + 1][1]); pw.z = pk2(sv[j][4 * sh + 2][0], sv[j][4 * sh + 2][1]); pw.w = pk2(sv[j][4 * sh + 3][0], sv[j][4 * sh + 3][1]);
                const bf16x8 pf = __builtin_bit_cast(bf16x8, pw);
#pragma unroll
                for (int dt = 0; dt < 2; ++dt) o[dt] = __builtin_amdgcn_mfma_f32_32x32x16_bf16(vf[j & 1][sh * 2 + dt], pf, o[dt], 0, 0, 0);
            }
            __builtin_amdgcn_sched_barrier(0);
        }
        float l = l2[0] + l2[1];
        { const auto sw = __builtin_amdgcn_permlane32_swap(__float_as_uint(l), __float_as_uint(l), false, false); l = __uint_as_float(sw[0]) + __uint_as_float(sw[1]); }
        l += __builtin_amdgcn_exp2f(sink2 - mx);
        const float inv = __builtin_amdgcn_rcpf(l);
        f32x2 ov[2][8]; f32x2 ss2 = (f32x2){0.f, 0.f}; const f32x2 inv2 = (f32x2){inv, inv};
#pragma unroll
        for (int dt = 0; dt < 2; ++dt)
#pragma unroll
            for (int r2 = 0; r2 < 8; ++r2) { ov[dt][r2] = (f32x2){o[dt][2 * r2], o[dt][2 * r2 + 1]} * inv2; ss2 += ov[dt][r2] * ov[dt][r2]; }
        float ss = ss2[0] + ss2[1];
        { const auto sw = __builtin_amdgcn_permlane32_swap(__float_as_uint(ss), __float_as_uint(ss), false, false); ss = __uint_as_float(sw[0]) + __uint_as_float(sw[1]); }
        LAS float* X = (LAS float*)(lds + L_SSQ) + (rb & 1) * 256;
        if (hi == 0) X[h * 32 + r32] = ss;
        __syncthreads();
        float tot = 0.f;
#pragma unroll
        for (int hh = 0; hh < 8; ++hh) tot += X[hh * 32 + r32];
        const float rr = rsqrtf(tot * (1.0f / 512.0f) + EPS);
        bf16* op = mix + (rowbase + rb * 32 + r32) * 1024 + h * 64 + 8 * hi;
        const f32x2 rr2 = (f32x2){rr, rr};
#pragma unroll
        for (int dt = 0; dt < 2; ++dt)
#pragma unroll
            for (int k = 0; k < 4; k += 2) {
                const f32x2 a0 = ov[dt][2 * k] * rr2, a1 = ov[dt][2 * k + 1] * rr2, b0 = ov[dt][2 * k + 2] * rr2, b1 = ov[dt][2 * k + 3] * rr2;
                unsigned ax = pk2(a0[0], a0[1]), ay = pk2(a1[0], a1[1]), bx_ = pk2(b0[0], b0[1]), by = pk2(b1[0], b1[1]);
                { const auto r = __builtin_amdgcn_permlane32_swap(ax, bx_, false, false); ax = r[0]; bx_ = r[1]; }
                { const auto r = __builtin_amdgcn_permlane32_swap(ay, by, false, false); ay = r[0]; by = r[1]; }
                u32x4 w; w.x = ax; w.y = ay; w.z = bx_; w.w = by;
                *(u32x4*)(op + dt * 32 + 8 * k) = w; }
    }
}

constexpr int CT = 16, CWIN = CT + 30, CITEM = 2 * CT;
template <int S> __device__ __forceinline__ unsigned conv_ld(const bf16* hp, int tt) {
    unsigned hv = 0u; if (S >= 30 || tt - 30 + S >= 0) hv = *(const unsigned*)(hp + (long)S * 512); return hv;
}
template <int S> __device__ __forceinline__ void conv_fma(f32x2 (&acc)[CT], const f32x2 (&w)[31], unsigned hv) {
    f32x2 hf; hf[0] = __uint_as_float(hv << 16); hf[1] = __uint_as_float(hv & 0xffff0000u);
#pragma unroll
    for (int j = 0; j < 31; ++j) { const int tok = S - j; if (tok >= 0 && tok < CT) acc[tok] += w[j] * hf; }
}
template <int... I> __device__ __forceinline__ void conv_load_all(std::integer_sequence<int, I...>, unsigned (&hv)[CWIN], const bf16* hp, int tt) { ((hv[I] = conv_ld<I>(hp, tt)), ...); }
template <int... I> __device__ __forceinline__ void conv_fma_all(std::integer_sequence<int, I...>, f32x2 (&acc)[CT], const f32x2 (&w)[31], const unsigned (&hv)[CWIN]) { (conv_fma<I>(acc, w, hv[I]), ...); }
__device__ __forceinline__ void conv_weights(f32x2 (&w)[31], f32x2& bias, const float* cw, const float* cb) {
    const int cp = tid_opaque() & 255;
#pragma unroll
    for (int j = 0; j < 31; ++j) w[j] = *(const f32x2*)(cw + j * 512 + 2 * cp);
    bias = *(const f32x2*)(cb + 2 * cp);
}
__device__ __forceinline__ void conv_phase(LAS unsigned char* lds, int bx, int G, const bf16* Hg, const float* cw, const float* cb, const float* lg, const float* lb, bf16* mix) {
    const int tid = tid_opaque(), cp = tid & 255, half = tid >> 8, lane = tid & 63, wave = tid >> 6;
    constexpr int NIT = M / CITEM;
    f32x2 w[31]; f32x2 bias; conv_weights(w, bias, cw, cb);
    const f32x4 g0 = *(const f32x4*)(lg + lane * 8), g1 = *(const f32x4*)(lg + lane * 8 + 4), b0 = *(const f32x4*)(lb + lane * 8), b1 = *(const f32x4*)(lb + lane * 8 + 4);
    unsigned hv[CWIN];
    const int per = (NIT + G - 1) / G, itend = (bx + 1) * per < NIT ? (bx + 1) * per : NIT;
    int it = bx * per, par = 0;
    if (it < itend) { const int ts = it * CITEM + half * CT; conv_load_all(std::make_integer_sequence<int, CWIN>{}, hv, Hg + ((long)ts - 30) * 512 + 2 * cp, ts & (T - 1)); }
#pragma unroll 1
    for (; it < itend; ++it, par ^= 1) {
        f32x2 acc[CT];
#pragma unroll
        for (int k = 0; k < CT; ++k) acc[k] = bias;
        conv_fma_all(std::make_integer_sequence<int, CWIN>{}, acc, w, hv);
        LAS float* Y = (LAS float*)lds + par * (CITEM * 512);
#pragma unroll
        for (int k = 0; k < CT; ++k) *(LAS f32x2*)(Y + (half * CT + k) * 512 + 2 * cp) = acc[k];
        { const int nit = it + 1; if (nit < itend) { const int ts = nit * CITEM + half * CT; conv_load_all(std::make_integer_sequence<int, CWIN>{}, hv, Hg + ((long)ts - 30) * 512 + 2 * cp, ts & (T - 1)); } }
        __syncthreads();
        constexpr int NT = CITEM / 8;
        f32x4 y0[NT], y1[NT]; float red[NT];
#pragma unroll
        for (int k = 0; k < NT; ++k) { const int tok = wave * NT + k; y0[k] = *(const LAS f32x4*)(Y + tok * 512 + lane * 8); y1[k] = *(const LAS f32x4*)(Y + tok * 512 + lane * 8 + 4); }
#pragma unroll
        for (int k = 0; k < NT; ++k) red[k] = ((y0[k][0] + y0[k][1]) + (y0[k][2] + y0[k][3])) + ((y1[k][0] + y1[k][1]) + (y1[k][2] + y1[k][3]));
#pragma unroll
        for (int k = 0; k < NT; ++k) red[k] = wave_sum(red[k]) * (1.0f / 512.0f);
#pragma unroll
        for (int k = 0; k < NT; ++k) { y0[k] = y0[k] - red[k]; y1[k] = y1[k] - red[k]; const f32x4 q0 = y0[k] * y0[k], q1 = y1[k] * y1[k]; red[k] = ((q0[0] + q0[1]) + (q0[2] + q0[3])) + ((q1[0] + q1[1]) + (q1[2] + q1[3])); }
#pragma unroll
        for (int k = 0; k < NT; ++k) red[k] = rsqrtf(wave_sum(red[k]) * (1.0f / 512.0f) + EPS);
#pragma unroll
        for (int k = 0; k < NT; ++k) { y0[k] = y0[k] * red[k] * g0 + b0; y1[k] = y1[k] * red[k] * g1 + b1; float ss = 0.f;
#pragma unroll
            for (int i = 0; i < 4; ++i) { y0[k][i] = y0[k][i] * __builtin_amdgcn_rcpf(1.0f + __expf(-y0[k][i])); y1[k][i] = y1[k][i] * __builtin_amdgcn_rcpf(1.0f + __expf(-y1[k][i])); ss += y0[k][i] * y0[k][i] + y1[k][i] * y1[k][i]; }
            red[k] = ss; }
#pragma unroll
        for (int k = 0; k < NT; ++k) red[k] = rsqrtf(wave_sum(red[k]) * (1.0f / 512.0f) + EPS);
#pragma unroll
        for (int k = 0; k < NT; ++k) { const int tok = wave * NT + k; const float rr = red[k];
            u32x4 o; o.x = pk2(y0[k][0] * rr, y0[k][1] * rr); o.y = pk2(y0[k][2] * rr, y0[k][3] * rr); o.z = pk2(y1[k][0] * rr, y1[k][1] * rr); o.w = pk2(y1[k][2] * rr, y1[k][3] * rr);
            *(u32x4*)(mix + ((size_t)it * CITEM + tok) * 1024 + 512 + lane * 8) = o; }
    }
    __syncthreads();
}

#ifndef MK_N_LAUNCHES
#define MK_N_LAUNCHES 1
#endif
#ifndef MLP_SPLIT
#define MLP_SPLIT 2
#endif
constexpr int PPL = 3 + 2 * MLP_SPLIT, NPHASE = 1 + PPL * DEPTH;
__global__ void __launch_bounds__(512, 2) fwd_kernel(Args a) {
    extern __shared__ __attribute__((aligned(16))) unsigned char lds_raw[];
    LAS unsigned char* lds = (LAS unsigned char*)lds_raw;
    cg::grid_group grid = cg::this_grid();
    const int G = gridDim.x, bx = blockIdx.x, vcu = (G % 8 == 0) ? (bx % 8) * (G / 8) + bx / 8 : bx;
    const int lo = a.ph_lo, hi = a.ph_hi;
#define IN(k) (lo <= (k) && (k) < hi)
    volatile LAS unsigned* MISC = (volatile LAS unsigned*)(lds + MISC_OFF);
    if (threadIdx.x < 64) MISC[threadIdx.x] = 0u;
    __syncthreads();
    XcdBarrier bar; bar.bar = (unsigned*)(a.ws + WS_CTL); bar.x = 0; bar.st = nullptr;
    if (hi - lo > 1) bar = xcd_barrier_post((unsigned*)(a.ws + WS_CTL), MISC + 8);
#define SEAM(k) do { if ((k) + 1 < hi) { if ((k) == 0) grid.sync(); else xcd_barrier(bar); } } while (0)
    bf16* xb = (bf16*)(a.ws + WS_XB); float* ssq = (float*)(a.ws + WS_SSQ);
    bf16* Qb = (bf16*)(a.ws + WS_Q); bf16* Kb = (bf16*)(a.ws + WS_K); bf16* Vg = (bf16*)(a.ws + WS_V); bf16* Hg = (bf16*)(a.ws + WS_HG); bf16* mix = (bf16*)(a.ws + WS_MIX); bf16* hid = (bf16*)(a.ws + WS_HID);
    if (IN(0)) { prologue(a, lds, vcu, G); __syncthreads(); SEAM(0); }
#pragma unroll 1
    for (int l = 0; l < DEPTH; ++l) {
        const int k0 = 1 + PPL * l;
        if (IN(k0)) {
            pg8::Gemm g{xb, (const bf16*)(a.ws + WS_WIN + l * SZ_WIN), M, INW, D}; pg8::StaticOrder S; S.init(M, INW, G, bx);
            pg8::EpiIn E{ssq, a.q_norm_g + l * 64, a.k_norm_g + l * 64, Qb, Kb, Vg, Hg};
            pg8::gemm_phase<pg8::EpiIn, pg8::StaticOrder, true, true, true>(lds, g, S, E);
            if (l + 1 < DEPTH) {
                constexpr int NU = (M / 256) * (INW / 256); const int rounds = (NU + G - 1) / G, nlast = NU - (rounds - 1) * G, first = (nlast >= G) ? 0 : nlast;
                if (bx >= first) convert_layer(a, lds, l + 1, (bx - first) * 8 + (tid_opaque() >> 6), (G - first) * 8);
            }
            SEAM(k0);
        }
        if (IN(k0 + 1)) {
            attn_bias_table(lds, a.rel_bias);
            for (int it = vcu; it < NB * (T / 128); it += G) { const int b = it / (T / 128), qb = it % (T / 128);
                __syncthreads(); attn_stage(lds, b, qb, Kb, Vg); __syncthreads();
                attn_compute(lds, b, qb, Qb, mix, a.sinks + l * 8); }
            __syncthreads();
            conv_phase(lds, vcu, G, Hg, a.conv_w + (size_t)l * 31 * 512, a.conv_b + l * 512, a.conv_ln_g + l * 512, a.conv_ln_b + l * 512, mix);
            SEAM(k0 + 1);
        }
        if (IN(k0 + 2)) {
            pg8::Gemm g{mix, (const bf16*)(a.ws + WS_WOUT + l * SZ_WOUT), M, D, D}; pg8::StaticOrder S; S.init(M, D, G, bx);
#if RES_BF16
            pg8::EpiRes E{nullptr, nullptr, xb, ssq};
#else
            pg8::EpiRes E{l == 0 ? a.x : a.out, a.out, xb, ssq};
#endif
            pg8::gemm_phase<pg8::EpiRes, pg8::StaticOrder, true, true, true>(lds, g, S, E);
            SEAM(k0 + 2);
        }
#pragma unroll 1
        for (int hf = 0; hf < MLP_SPLIT; ++hf) {
            constexpr int MS = M / MLP_SPLIT; const size_t r0 = (size_t)hf * MS;
            const int ku = k0 + 3 + 2 * hf, kd = ku + 1;
            if (IN(ku)) {
                pg8::Gemm g{xb + r0 * D, (const bf16*)(a.ws + WS_WUP + l * SZ_WUP), MS, FF, D}; pg8::StaticOrder S; S.init(MS, FF, G, bx);
                pg8::EpiUp E{ssq + r0 * 16, hid};
                pg8::gemm_phase<pg8::EpiUp, pg8::StaticOrder, true, true, true>(lds, g, S, E);
                SEAM(ku);
            }
            if (IN(kd)) {
                pg8::Gemm g{hid, (const bf16*)(a.ws + WS_WDN + l * SZ_WDN), MS, D, FF}; pg8::StaticOrder S; S.init(MS, D, G, bx);
#if RES_BF16
                pg8::EpiRes E{nullptr, l == DEPTH - 1 ? a.out + r0 * D : nullptr, xb + r0 * D, ssq + r0 * 16};
#else
                pg8::EpiRes E{a.out + r0 * D, a.out + r0 * D, xb + r0 * D, ssq + r0 * 16};
#endif
                pg8::gemm_phase<pg8::EpiRes, pg8::StaticOrder, true, true, true>(lds, g, S, E);
                SEAM(kd);
            }
        }
    }
#undef IN
#undef SEAM
}

extern "C" void kernel_launch(void* const* d_in, const int* in_sizes, int n_in, void* d_out, int out_size, void* d_ws, size_t ws_size, hipStream_t stream) {
    static int grid = 0;
    if (grid == 0) {
        if (n_in != 17 || in_sizes[0] != M * D || out_size != M * D || ws_size < WS_END) { fprintf(stderr, "kernel_launch: unexpected shapes (n_in %d, in0 %d, out %d, ws %zu); nothing launched\n", n_in, n_in > 0 ? in_sizes[0] : -1, out_size, ws_size); grid = -1; return; }
        int dev = 0, cus = 0, per_cu = 0;
        if (hipGetDevice(&dev) != hipSuccess || hipDeviceGetAttribute(&cus, hipDeviceAttributeMultiprocessorCount, dev) != hipSuccess) { grid = -1; return; }
        if (hipFuncSetAttribute((const void*)fwd_kernel, hipFuncAttributeMaxDynamicSharedMemorySize, LDS_BYTES) != hipSuccess) { fprintf(stderr, "kernel_launch: hipFuncSetAttribute failed\n"); grid = -1; return; }
        if (hipOccupancyMaxActiveBlocksPerMultiprocessor(&per_cu, (const void*)fwd_kernel, 512, LDS_BYTES) != hipSuccess || per_cu < 1) { fprintf(stderr, "kernel_launch: occupancy query says %d\n", per_cu); per_cu = 1; }
        (void)hipGetLastError();
        grid = cus * per_cu;
        if (M % grid != 0 || (M / grid) % 32 != 0) { fprintf(stderr, "kernel_launch: grid %d does not divide the rows into 32-row multiples; nothing launched\n", grid); grid = -1; return; }
    }
    if (grid < 0) return;
    Args a{};
    const float** p = (const float**)&a;
    for (int i = 0; i < 17; ++i) p[i] = (const float*)d_in[i];
    a.out = (float*)d_out; a.ws = (unsigned char*)d_ws;
#if MK_N_LAUNCHES == 1
    if (hipMemsetAsync((char*)d_ws + WS_CTL, 0, CTL_ZERO_BYTES, stream) != hipSuccess) { fprintf(stderr, "kernel_launch: memset of the barrier words failed\n"); return; }
    a.ph_lo = 0; a.ph_hi = NPHASE;
    void* args[] = {&a};
    hipError_t e = hipLaunchCooperativeKernel((const void*)fwd_kernel, dim3(grid), dim3(512), args, LDS_BYTES, stream);
    if (e != hipSuccess) fprintf(stderr, "kernel_launch: cooperative launch failed: %s (grid %d)\n", hipGetErrorString(e), grid);
#else
    for (int ph = 0; ph < NPHASE; ++ph) { a.ph_lo = ph; a.ph_hi = ph + 1; hipLaunchKernelGGL(fwd_kernel, dim3(grid), dim3(512), LDS_BYTES, stream, a); }
#endif
}
```

```cpp
#include <hip/hip_runtime.h>
#include <hip/hip_cooperative_groups.h>
#include <cstdio>
#include <cstdint>
#include <utility>
namespace cg = cooperative_groups;
namespace pg8 {
#define PG8_LAS __attribute__((address_space(3)))
typedef unsigned short bf16_t;
typedef short bf16x8 __attribute__((ext_vector_type(8)));
typedef float f32x4 __attribute__((ext_vector_type(4)));
typedef unsigned u32x4 __attribute__((ext_vector_type(4)));
constexpr int BM = 256, BK = 64, HALF = 128, HTB = HALF * BK * 2  , STAGE_BYTES = 8 * HTB, NXCD = 8, WGM = 8;

__host__ __device__ __forceinline__ int lds_byte(int r, int c) { const int st = (r >> 4) * 2 + (c >> 5), rr = r & 15, cc = c & 31, ob = rr * 64 + cc * 2; return st * 1024 + (ob ^ (((ob >> 9) & 1) << 5)); }
__host__ __device__ __forceinline__ void stage_rc(int b, int& R, int& C) { const int st = b / 1024, sb = b % 1024, swz = sb ^ (((sb >> 9) & 1) << 5); R = (st >> 1) * 16 + swz / 64; C = (st & 1) * 32 + (swz % 64) / 2; }
__host__ __device__ __forceinline__ int perm32(int rho) { const int n = rho >> 4, i = rho & 15; return 8 * (i >> 2) + 4 * n + (i & 3); }

struct Unit { int pm, pn; };
struct Gemm { const bf16_t* A; const bf16_t* Bt; int M, N, K; };

struct StaticOrder {
    int nM, nN, nwg, G, c;
    __host__ __device__ void init(int M, int N, int G_, int c_) { nM = M / BM; nN = N / BM; nwg = nM * nN; G = G_; c = c_; }
    __host__ __device__ bool next(int i, Unit& u) const {
        const long L = (long)i * G + c; if (L >= nwg) return false;
        int wgid = (int)L; { const int q = nwg / NXCD, r = nwg % NXCD, xcd = wgid % NXCD, off = wgid / NXCD; wgid = (xcd < r ? xcd * (q + 1) : r * (q + 1) + (xcd - r) * q) + off; }
        const int nig = WGM * nN, gid = wgid / nig, fm = gid * WGM, gsz = (nM - fm) < WGM ? (nM - fm) : WGM;
        u.pm = fm + ((wgid % nig) % gsz); u.pn = (wgid % nig) / gsz; return true;
    }
    __device__ __forceinline__ void a_ready(const Unit&) const {}
    __device__ __forceinline__ void done(const Unit&) const {}
};

__device__ __forceinline__ unsigned cvt_pk_bf16(float lo, float hi) { unsigned r; asm volatile("v_cvt_pk_bf16_f32 %0, %1, %2" : "=v"(r) : "v"(lo), "v"(hi)); return r; }
typedef float f32x2 __attribute__((ext_vector_type(2)));
constexpr float EPS_ = 1e-6f;
constexpr int TT = 8192;
constexpr float QSCALE = 0.125f * 1.4426950408889634f;
__device__ __forceinline__ float xsum4(float s) {
    const auto a = __builtin_amdgcn_permlane16_swap(__float_as_uint(s), __float_as_uint(s), false, false); s = __uint_as_float(a[0]) + __uint_as_float(a[1]);
    const auto b = __builtin_amdgcn_permlane32_swap(__float_as_uint(s), __float_as_uint(s), false, false); return __uint_as_float(b[0]) + __uint_as_float(b[1]);
}
__device__ __forceinline__ float row_rstd(const float* ssq, int row, int fq) {
    const f32x4 p = *(const f32x4*)(ssq + (size_t)row * 16 + fq * 4);
    float s = (p[0] + p[1]) + (p[2] + p[3]); s = xsum4(s);
    return rsqrtf(s * (1.0f / 1024.0f) + EPS_);
}
__device__ __forceinline__ u32x4 pack8(const f32x4 a, const f32x4 b) { u32x4 w; w.x = cvt_pk_bf16(a[0], a[1]); w.y = cvt_pk_bf16(a[2], a[3]); w.z = cvt_pk_bf16(b[0], b[1]); w.w = cvt_pk_bf16(b[2], b[3]); return w; }

__device__ __forceinline__ void zero_acc(f32x4 (&acc)[2][2][4][2]) {
#pragma unroll
    for (int a = 0; a < 2; ++a)
#pragma unroll
        for (int b = 0; b < 2; ++b)
#pragma unroll
            for (int m = 0; m < 4; ++m)
#pragma unroll
                for (int n = 0; n < 2; ++n) acc[a][b][m][n] = (f32x4){0.f, 0.f, 0.f, 0.f};
}
struct EpiIn {
    static constexpr bool PERM = true, AFTER_DRAIN = false;
    const float* ssq; const float* qg; const float* kg;
    bf16_t* Q; bf16_t* Kb; bf16_t* Vg; bf16_t* Hg;
    __device__ __forceinline__ void init(f32x4 (&acc)[2][2][4][2], const Unit&, int, int, int, int) const { zero_acc(acc); }
    __device__ __forceinline__ void operator()(const f32x4 (&acc)[2][2][4][2], const Unit& u, int wr, int wc, int fr, int fq) const {
        const int pn = u.pn;
        float rsv[2][4];
        { f32x4 pv[2][4];
#pragma unroll
          for (int ai = 0; ai < 2; ++ai)
#pragma unroll
              for (int m = 0; m < 4; ++m) pv[ai][m] = *(const f32x4*)(ssq + (size_t)(u.pm * BM + ai * HALF + wr * 64 + m * 16 + fr) * 16 + fq * 4);
          __builtin_amdgcn_sched_barrier(0);
#pragma unroll
          for (int ai = 0; ai < 2; ++ai)
#pragma unroll
              for (int m = 0; m < 4; ++m) { const f32x4 p = pv[ai][m]; rsv[ai][m] = rsqrtf(xsum4((p[0] + p[1]) + (p[2] + p[3])) * (1.0f / 1024.0f) + EPS_); } }
        if (pn >= 3) {
#pragma unroll
            for (int ai = 0; ai < 2; ++ai)
#pragma unroll
                for (int m = 0; m < 4; ++m) {
                    const int row = u.pm * BM + ai * HALF + wr * 64 + m * 16 + fr; const float rs = rsv[ai][m];
                    f32x4 h[2];
#pragma unroll
                    for (int n = 0; n < 2; ++n)
#pragma unroll
                        for (int i = 0; i < 4; ++i) { const float uu = acc[ai][0][m][n][i] * rs, gg = acc[ai][1][m][n][i] * rs; h[n][i] = uu * __builtin_amdgcn_rcpf(1.0f + __expf(-gg)); }
                    *(u32x4*)(Hg + (size_t)row * 512 + (pn - 3) * 128 + wc * 32 + fq * 8) = pack8(h[0], h[1]);
                }
        } else if (pn < 2 || wc < 2) {
            const bool isq = pn < 2; const float* g = isq ? qg : kg; const float osc = isq ? QSCALE : 1.0f;
            bf16_t* base = isq ? Q + (pn * 4 + wc) * 64 : Kb + wc * 64; const int ld = isq ? 512 : 128;
            f32x4 gv[2][2];
#pragma unroll
            for (int bj = 0; bj < 2; ++bj)
#pragma unroll
                for (int n = 0; n < 2; ++n) gv[bj][n] = *(const f32x4*)(g + bj * 32 + fq * 8 + n * 4);
#pragma unroll
            for (int ai = 0; ai < 2; ++ai)
#pragma unroll
                for (int m = 0; m < 4; ++m) {
                    const int row = u.pm * BM + ai * HALF + wr * 64 + m * 16 + fr; const float rs = rsv[ai][m];
                    f32x4 v[2][2]; float ss = 0.f;
#pragma unroll
                    for (int bj = 0; bj < 2; ++bj)
#pragma unroll
                        for (int n = 0; n < 2; ++n) { v[bj][n] = acc[ai][bj][m][n] * rs; const f32x4 q = v[bj][n] * v[bj][n]; ss += (q[0] + q[1]) + (q[2] + q[3]); }
                    ss = xsum4(ss); const float r = rsqrtf(ss * (1.0f / 64.0f) + EPS_) * osc;
#pragma unroll
                    for (int bj = 0; bj < 2; ++bj) *(u32x4*)(base + (size_t)row * ld + bj * 32 + fq * 8) = pack8(v[bj][0] * gv[bj][0] * r, v[bj][1] * gv[bj][1] * r);
                }
        } else {
            const int kvh = wc - 2;
#pragma unroll
            for (int ai = 0; ai < 2; ++ai)
#pragma unroll
                for (int m = 0; m < 4; ++m) {
                    const int row = u.pm * BM + ai * HALF + wr * 64 + m * 16 + fr; const float rs = rsv[ai][m];
                    const int b = row / TT, t = row % TT;
#pragma unroll
                    for (int bj = 0; bj < 2; ++bj) { const int dc = bj * 4 + fq;
                        *(u32x4*)(Vg + ((size_t)((b * 2 + kvh) * 8 + dc) * TT + t) * 8) = pack8(acc[ai][bj][m][0] * rs, acc[ai][bj][m][1] * rs); }
                }
        }
    }
};
#ifndef RES_BF16
#define RES_BF16 1
#endif
struct EpiRes {
    static constexpr bool PERM = true, AFTER_DRAIN = false;
    const float* resid; float* xout; bf16_t* xb; float* ssq;
    __device__ __forceinline__ void init(f32x4 (&acc)[2][2][4][2], const Unit& u, int wr, int wc, int fr, int fq) const {
        if (resid) {
#pragma unroll
            for (int ai = 0; ai < 2; ++ai)
#pragma unroll
                for (int m = 0; m < 4; ++m) { const int row = u.pm * BM + ai * HALF + wr * 64 + m * 16 + fr;
#pragma unroll
                    for (int bj = 0; bj < 2; ++bj) { const size_t off = (size_t)row * 1024 + u.pn * BM + bj * HALF + wc * 32 + fq * 8;
                        acc[ai][bj][m][0] = *(const f32x4*)(resid + off); acc[ai][bj][m][1] = *(const f32x4*)(resid + off + 4); } }
        } else {
            u32x4 w[2][4][2];
#pragma unroll
            for (int ai = 0; ai < 2; ++ai)
#pragma unroll
                for (int m = 0; m < 4; ++m) { const int row = u.pm * BM + ai * HALF + wr * 64 + m * 16 + fr;
#pragma unroll
                    for (int bj = 0; bj < 2; ++bj) w[ai][m][bj] = *(const u32x4*)(xb + (size_t)row * 1024 + u.pn * BM + bj * HALF + wc * 32 + fq * 8); }
            __builtin_amdgcn_sched_barrier(0);
#pragma unroll
            for (int ai = 0; ai < 2; ++ai)
#pragma unroll
                for (int m = 0; m < 4; ++m)
#pragma unroll
                    for (int bj = 0; bj < 2; ++bj) { const u32x4 x = w[ai][m][bj];
                        acc[ai][bj][m][0] = (f32x4){__uint_as_float(x.x << 16), __uint_as_float(x.x & 0xffff0000u), __uint_as_float(x.y << 16), __uint_as_float(x.y & 0xffff0000u)};
                        acc[ai][bj][m][1] = (f32x4){__uint_as_float(x.z << 16), __uint_as_float(x.z & 0xffff0000u), __uint_as_float(x.w << 16), __uint_as_float(x.w & 0xffff0000u)}; }
        }
    }
    __device__ __forceinline__ void operator()(const f32x4 (&acc)[2][2][4][2], const Unit& u, int wr, int wc, int fr, int fq) const {
#pragma unroll
        for (int ai = 0; ai < 2; ++ai)
#pragma unroll
            for (int m = 0; m < 4; ++m) {
                const int row = u.pm * BM + ai * HALF + wr * 64 + m * 16 + fr; float ss = 0.f;
#pragma unroll
                for (int bj = 0; bj < 2; ++bj) { const size_t off = (size_t)row * 1024 + u.pn * BM + bj * HALF + wc * 32 + fq * 8;
                    const f32x4 v0 = acc[ai][bj][m][0], v1 = acc[ai][bj][m][1];
                    if (xout) { __builtin_nontemporal_store(v0, (f32x4*)(xout + off)); __builtin_nontemporal_store(v1, (f32x4*)(xout + off + 4)); }
                    *(u32x4*)(xb + off) = pack8(v0, v1);
                    const f32x4 q0 = v0 * v0, q1 = v1 * v1; ss += ((q0[0] + q0[1]) + (q0[2] + q0[3])) + ((q1[0] + q1[1]) + (q1[2] + q1[3])); }
                ss = xsum4(ss);
                if (fq == 0) ssq[(size_t)row * 16 + u.pn * 4 + wc] = ss;
            }
    }
};
struct EpiUp {
    static constexpr bool PERM = true, AFTER_DRAIN = false;
    const float* ssq; bf16_t* Hid;
    __device__ __forceinline__ void init(f32x4 (&acc)[2][2][4][2], const Unit&, int, int, int, int) const { zero_acc(acc); }
    __device__ __forceinline__ void operator()(const f32x4 (&acc)[2][2][4][2], const Unit& u, int wr, int wc, int fr, int fq) const {
        float rsv[2][4];
        { f32x4 pv[2][4];
#pragma unroll
          for (int ai = 0; ai < 2; ++ai)
#pragma unroll
              for (int m = 0; m < 4; ++m) pv[ai][m] = *(const f32x4*)(ssq + (size_t)(u.pm * BM + ai * HALF + wr * 64 + m * 16 + fr) * 16 + fq * 4);
          __builtin_amdgcn_sched_barrier(0);
#pragma unroll
          for (int ai = 0; ai < 2; ++ai)
#pragma unroll
              for (int m = 0; m < 4; ++m) { const f32x4 p = pv[ai][m]; rsv[ai][m] = rsqrtf(xsum4((p[0] + p[1]) + (p[2] + p[3])) * (1.0f / 1024.0f) + EPS_); } }
#pragma unroll
        for (int ai = 0; ai < 2; ++ai)
#pragma unroll
            for (int m = 0; m < 4; ++m) {
                const int row = u.pm * BM + ai * HALF + wr * 64 + m * 16 + fr; const float rs = rsv[ai][m];
#pragma unroll
                for (int bj = 0; bj < 2; ++bj) { f32x4 v0 = acc[ai][bj][m][0] * rs, v1 = acc[ai][bj][m][1] * rs;
#pragma unroll
                    for (int i = 0; i < 4; ++i) { const float a = fmaxf(v0[i], 0.f), b = fmaxf(v1[i], 0.f); v0[i] = a * a; v1[i] = b * b; }
                    *(u32x4*)(Hid + (size_t)row * 4096 + u.pn * BM + bj * HALF + wc * 32 + fq * 8) = pack8(v0, v1); }

            }
    }
};
template <class Epi, class Sched, bool ALIGN_EPI = false, bool SP2 = false, bool ZZ = false>
__device__ __forceinline__ void gemm_phase(PG8_LAS unsigned char* lds, const Gemm g, const Sched& S, const Epi& E) {
    int tid_ = threadIdx.x; asm volatile("" : "+v"(tid_));
    const int tid = tid_, wid = __builtin_amdgcn_readfirstlane(tid >> 6), lane = tid & 63, wr = wid >> 2, wc = wid & 3, fr = lane & 15, fq = lane >> 4;
    const int K = g.K, nt = K / BK;
    unsigned voffA[2], voffB[2];
#pragma unroll
    for (int i = 0; i < 2; ++i) { int R, C; stage_rc(tid * 16 + i * 8192, R, C); const int Rb = Epi::PERM ? ((R & ~31) + perm32(R & 31)) : R;
        voffA[i] = (unsigned)(R * K + C) * 2u; voffB[i] = (unsigned)(Rb * K + C) * 2u; }
    const long kstep = (long)(BK * 2);
    const size_t hstep = (size_t)HALF * K * 2;
    const size_t tstep = 2 * hstep;
    const unsigned ldsw = (unsigned)wid * 1024u;
    const int aoff = lds_byte(wr * 64 + fr, fq * 8), boff = lds_byte(wc * 32 + fr, fq * 8);
#define PG8_SA(b, h) (((b) * 2 + (h)) * HTB)
#define PG8_SB(b, h) ((4 + (b) * 2 + (h)) * HTB)
#define PG8_STAGE(bufoff, gbase, voff) do { _Pragma("unroll") for (int _i = 0; _i < 2; ++_i) \
        __builtin_amdgcn_global_load_lds((const unsigned*)((const char*)(gbase) + (voff)[_i]), (PG8_LAS unsigned*)(lds + (bufoff) + ldsw + _i * 8192), 16, 0, 0); } while (0)
#define PG8_LDA(dst, b, h) do { _Pragma("unroll") for (int m = 0; m < 4; ++m) _Pragma("unroll") for (int k = 0; k < 2; ++k) dst[m][k] = *(const PG8_LAS bf16x8*)(lds + PG8_SA(b, h) + aoff + m * 2048 + k * 1024); } while (0)
#define PG8_LDB(dst, b, h) do { _Pragma("unroll") for (int n = 0; n < 2; ++n) _Pragma("unroll") for (int k = 0; k < 2; ++k) dst[n][k] = *(const PG8_LAS bf16x8*)(lds + PG8_SB(b, h) + boff + n * 2048 + k * 1024); } while (0)
#define PG8_MMA(ai, bj, At, Bt) do { __builtin_amdgcn_s_setprio(1); _Pragma("unroll") for (int m = 0; m < 4; ++m) _Pragma("unroll") for (int n = 0; n < 2; ++n) _Pragma("unroll") for (int k = 0; k < 2; ++k) \
        acc[ai][bj][m][n] = __builtin_amdgcn_mfma_f32_16x16x32_bf16(Bt[n][k], At[m][k], acc[ai][bj][m][n], 0, 0, 0); __builtin_amdgcn_s_setprio(0); } while (0)
#define PG8_WAIT_V(n) asm volatile("s_waitcnt vmcnt(" #n ")" ::: "memory")
#define PG8_WAIT_L(n) asm volatile("s_waitcnt lgkmcnt(" #n ")" ::: "memory")
#define PG8_BAR __builtin_amdgcn_s_barrier()
#define PG8_SCHED __builtin_amdgcn_sched_barrier(0)
    Unit cur, nxt; int ui = 0;
    if (!S.next(0, cur)) return;
    f32x4 acc[2][2][4][2];
    E.init(acc, cur, wr, wc, fr, fq);
    bf16x8 At[4][2], B0[2][2], B1[2][2];
    const char* cA = (const char*)g.A + (size_t)cur.pm * tstep; const char* cB = (const char*)g.Bt + (size_t)cur.pn * tstep;
    long ks = kstep, ksn = kstep;
    S.a_ready(cur);
    if constexpr (SP2) {
        PG8_STAGE(PG8_SB(0, 0), cB, voffB); PG8_STAGE(PG8_SB(0, 1), cB + hstep, voffB); PG8_STAGE(PG8_SA(0, 0), cA, voffA); PG8_STAGE(PG8_SA(0, 1), cA + hstep, voffA);
        if (wr == 1) PG8_BAR;
        PG8_WAIT_V(2); PG8_BAR;
        PG8_STAGE(PG8_SB(1, 0), cB + kstep, voffB); PG8_STAGE(PG8_SA(1, 0), cA + kstep, voffA); PG8_STAGE(PG8_SB(1, 1), cB + hstep + kstep, voffB);
        PG8_WAIT_V(6); PG8_BAR;
    } else {
        PG8_STAGE(PG8_SB(0, 0), cB, voffB); PG8_STAGE(PG8_SA(0, 0), cA, voffA); PG8_STAGE(PG8_SB(0, 1), cB + hstep, voffB); PG8_STAGE(PG8_SA(0, 1), cA + hstep, voffA);
        if (wr == 1) PG8_BAR;
        PG8_WAIT_V(4); PG8_BAR;
        PG8_STAGE(PG8_SB(1, 0), cB + kstep, voffB); PG8_STAGE(PG8_SA(1, 0), cA + kstep, voffA); PG8_STAGE(PG8_SB(1, 1), cB + hstep + kstep, voffB);
        PG8_WAIT_V(6); PG8_BAR;
    }
    for (;;) {
        const bool has_next = S.next(ui + 1, nxt);
        const bool nrev = ZZ && has_next && (((ui + 1) & 1) != 0); const long noff = nrev ? (long)(nt - 1) * kstep : 0l;
        ksn = has_next ? (nrev ? -kstep : kstep) : ks;
        const char* nA = has_next ? (const char*)g.A + (size_t)nxt.pm * tstep + noff : cA; const char* nB = has_next ? (const char*)g.Bt + (size_t)nxt.pn * tstep + noff : cB;
        for (int t = 0; t < nt; t += 2) {
            const bool last = (t == nt - 2);
            const char* a1 = cA + (long)(t + 1) * ks;
            const char* a2 = last ? nA : cA + (long)(t + 2) * ks; const char* b2 = last ? nB : cB + (long)(t + 2) * ks;
            const long k3 = last ? ksn : ks; const char* a3 = a2 + k3; const char* b3 = b2 + k3;
            if (last && has_next) S.a_ready(nxt);
            if constexpr (SP2) {
            PG8_LDB(B0, 0, 0); PG8_LDB(B1, 0, 1); PG8_SCHED; PG8_LDA(At, 0, 0); PG8_STAGE(PG8_SA(1, 1), a1 + hstep, voffA);
            PG8_WAIT_V(8); PG8_WAIT_L(0); PG8_BAR; PG8_MMA(0, 0, At, B0); PG8_MMA(0, 1, At, B1); PG8_BAR; PG8_SCHED;
            PG8_LDA(At, 0, 1); PG8_STAGE(PG8_SB(0, 0), b2, voffB); PG8_STAGE(PG8_SB(0, 1), b2 + hstep, voffB); PG8_STAGE(PG8_SA(0, 0), a2, voffA);
            PG8_WAIT_V(8); PG8_WAIT_L(0); PG8_BAR; PG8_MMA(1, 0, At, B0); PG8_MMA(1, 1, At, B1); PG8_BAR; PG8_SCHED;
            PG8_LDB(B0, 1, 0); PG8_LDB(B1, 1, 1); PG8_SCHED; PG8_LDA(At, 1, 0); PG8_STAGE(PG8_SA(0, 1), a2 + hstep, voffA);
            PG8_WAIT_V(8); PG8_WAIT_L(0); PG8_BAR; PG8_MMA(0, 0, At, B0); PG8_MMA(0, 1, At, B1); PG8_BAR; PG8_SCHED;
            PG8_LDA(At, 1, 1); PG8_STAGE(PG8_SB(1, 0), b3, voffB); PG8_STAGE(PG8_SB(1, 1), b3 + hstep, voffB); PG8_STAGE(PG8_SA(1, 0), a3, voffA);
            PG8_WAIT_V(8); PG8_WAIT_L(0); PG8_BAR; PG8_MMA(1, 0, At, B0); PG8_MMA(1, 1, At, B1); PG8_BAR; PG8_SCHED;
            } else {
            PG8_LDB(B0, 0, 0); PG8_SCHED; PG8_LDA(At, 0, 0); PG8_STAGE(PG8_SA(1, 1), a1 + hstep, voffA);
            PG8_WAIT_L(8); PG8_BAR; PG8_WAIT_L(0); PG8_MMA(0, 0, At, B0); PG8_BAR; PG8_SCHED;
            PG8_LDB(B1, 0, 1); PG8_STAGE(PG8_SB(0, 0), b2, voffB);
            PG8_BAR; PG8_WAIT_L(0); PG8_MMA(0, 1, At, B1); PG8_BAR;
            PG8_LDA(At, 0, 1); PG8_STAGE(PG8_SA(0, 0), a2, voffA);
            PG8_BAR; PG8_WAIT_L(0); PG8_MMA(1, 0, At, B0); PG8_BAR; PG8_SCHED;
            PG8_STAGE(PG8_SB(0, 1), b2 + hstep, voffB);
            PG8_WAIT_V(6); PG8_BAR; PG8_MMA(1, 1, At, B1); PG8_BAR;
            PG8_LDB(B0, 1, 0); PG8_SCHED; PG8_LDA(At, 1, 0); PG8_STAGE(PG8_SA(0, 1), a2 + hstep, voffA);
            PG8_WAIT_L(8); PG8_BAR; PG8_WAIT_L(0); PG8_MMA(0, 0, At, B0); PG8_BAR; PG8_SCHED;
            PG8_LDB(B1, 1, 1); PG8_STAGE(PG8_SB(1, 0), b3, voffB);
            PG8_BAR; PG8_WAIT_L(0); PG8_MMA(0, 1, At, B1); PG8_BAR;
            PG8_LDA(At, 1, 1); PG8_STAGE(PG8_SA(1, 0), a3, voffA);
            PG8_BAR; PG8_WAIT_L(0); PG8_MMA(1, 0, At, B0); PG8_BAR; PG8_SCHED;
            PG8_STAGE(PG8_SB(1, 1), b3 + hstep, voffB);
            PG8_WAIT_V(6); PG8_BAR; PG8_MMA(1, 1, At, B1); PG8_BAR;
            }
        }
        if constexpr (ALIGN_EPI) { if (wr == 0) PG8_BAR; }
        if constexpr (!Epi::AFTER_DRAIN) { E(acc, cur, wr, wc, fr, fq); S.done(cur); }
        if (!has_next) break;
        E.init(acc, nxt, wr, wc, fr, fq);
        cur = nxt; cA = nA; cB = nB; ks = ksn; ++ui;
        if constexpr (ALIGN_EPI) { if (wr == 1) PG8_BAR; }
    }
    PG8_WAIT_V(0);
    if constexpr (!ALIGN_EPI) { if (wr == 0) PG8_BAR; }
    PG8_BAR;
    if constexpr (Epi::AFTER_DRAIN) { E.fused(acc, cur, wr, wc, fr, fq, lds, wid, lane); S.done(cur); }
#undef PG8_SA
#undef PG8_SB
#undef PG8_STAGE
#undef PG8_LDA
#undef PG8_LDB
#undef PG8_MMA
#undef PG8_WAIT_V
#undef PG8_WAIT_L
#undef PG8_BAR
#undef PG8_SCHED
}
}
#define LAS __attribute__((address_space(3)))
typedef unsigned short bf16;
typedef unsigned u32x4 __attribute__((ext_vector_type(4)));
typedef unsigned u32x2 __attribute__((ext_vector_type(2)));
typedef float f32x4 __attribute__((ext_vector_type(4)));
typedef float f32x2 __attribute__((ext_vector_type(2)));
typedef short bf16x8 __attribute__((ext_vector_type(8)));
typedef float f32x16 __attribute__((ext_vector_type(16)));

#define XB_TMO      128
#define XB_XCNT(j)  (256  + 64 * (j))
#define XB_XSUB(j)  (1280 + 64 * (j))
#define XB_XGEN(j)  (2304 + 64 * (j))
#define XB_TOP      3328
#define XB_TOPGEN   3392
#define XCD_BAR_WORDS 3456
#define XB_SPIN_CAP (1u << 18)

__device__ __forceinline__ unsigned xb_ld(unsigned* p)              { return __hip_atomic_load(p, __ATOMIC_RELAXED, __HIP_MEMORY_SCOPE_AGENT); }
__device__ __forceinline__ unsigned xb_add(unsigned* p, unsigned v) { return __hip_atomic_fetch_add(p, v, __ATOMIC_RELAXED, __HIP_MEMORY_SCOPE_AGENT); }
__device__ __forceinline__ unsigned xb_xcc_id() { return (unsigned)__builtin_amdgcn_s_getreg((3 << 11) | 20) & 0xFu; }
#define XB_SPIN(cond, bar) do { unsigned _sp = 0; while (cond) { __builtin_amdgcn_s_sleep(1); \
    if ((++_sp & 255u) == 0u) { if (xb_ld(&(bar)[XB_TMO])) break; if (_sp > XB_SPIN_CAP) { atomicAdd(&(bar)[XB_TMO], 1u); break; } } } } while (0)

struct XcdBarrier {
    unsigned* bar; unsigned x;
    volatile LAS unsigned* st;
};

__device__ __forceinline__ XcdBarrier xcd_barrier_post(unsigned* bar, volatile LAS unsigned* st) {
    XcdBarrier b; b.bar = bar; b.x = xb_xcc_id(); b.st = st;
    if (threadIdx.x == 0) (void)xb_add(&bar[XB_XCNT(b.x)], 1u);
    return b;
}
__device__ __forceinline__ void xcd_barrier_complete(unsigned* bar, unsigned x, unsigned& nloc, unsigned& nx) {
    const unsigned G = gridDim.x * gridDim.y * gridDim.z;
    unsigned sum, cnt, mine, sp = 0u;
    for (;;) {
        sum = 0u; cnt = 0u; mine = 0u;
#pragma unroll
        for (unsigned j = 0; j < 16; ++j) { const unsigned c = xb_ld(&bar[XB_XCNT(j)]); sum += c; cnt += (c > 0u) ? 1u : 0u; mine = (j == x) ? c : mine; }
        if (sum == G) break;
        __builtin_amdgcn_s_sleep(1);
        if ((++sp & 255u) == 0u) { if (xb_ld(&bar[XB_TMO])) break; if (sp > XB_SPIN_CAP) { atomicAdd(&bar[XB_TMO], 1u); break; } }
    }
    nloc = mine > 0u ? mine : 1u; nx = cnt > 0u ? cnt : 1u;
}

__device__ __forceinline__ void xcd_barrier(const XcdBarrier& b) {
    asm volatile("s_waitcnt vmcnt(0)" ::: "memory");
    __syncthreads();
    if (threadIdx.x == 0) {
        unsigned* bar = b.bar;
        __builtin_amdgcn_s_waitcnt(0);
        unsigned nloc = b.st[0], nx = b.st[1];
        if (nloc == 0u) { xcd_barrier_complete(bar, b.x, nloc, nx); b.st[0] = nloc; b.st[1] = nx; }
        const unsigned old = xb_add(&bar[XB_XSUB(b.x)], 1u);
        const unsigned gen = old / nloc;
        if (old + 1u == (gen + 1u) * nloc) {
            __builtin_amdgcn_fence(__ATOMIC_RELEASE, "agent");
            asm volatile("s_waitcnt vmcnt(0)" ::: "memory");
            const unsigned og = xb_add(&bar[XB_TOP], 1u);
            const unsigned tg = og / nx;
            if (og + 1u == (tg + 1u) * nx) xb_add(&bar[XB_TOPGEN], 1u);
            else XB_SPIN(xb_ld(&bar[XB_TOPGEN]) == tg, bar);
            __builtin_amdgcn_fence(__ATOMIC_ACQUIRE, "agent");
            xb_add(&bar[XB_XGEN(b.x)], 1u);
            asm volatile("s_waitcnt vmcnt(0)" ::: "memory");
        } else {
            XB_SPIN(xb_ld(&bar[XB_XGEN(b.x)]) == gen, bar);
            __builtin_amdgcn_fence(__ATOMIC_ACQUIRE, "agent");
            asm volatile("s_waitcnt vmcnt(0)" ::: "memory");
        }
    }
    __syncthreads();
}

constexpr int NB = 4, T = 8192, D = 1024, M = NB * T, DEPTH = 4, INW = 1792, FF = 4096;
constexpr float EPS = 1e-6f, LOG2E = 1.4426950408889634f;
constexpr size_t MiB = 1u << 20;
constexpr size_t WS_WIN = 1 * MiB, WS_WOUT = 16 * MiB, WS_WUP = 24 * MiB, WS_WDN = 56 * MiB, WS_XB = 88 * MiB, WS_SSQ = 152 * MiB;
constexpr size_t WS_Q = 154 * MiB, WS_K = 186 * MiB, WS_V = 194 * MiB, WS_HG = 202 * MiB, WS_MIX = 234 * MiB;
constexpr size_t WS_HID = 154 * MiB, WS_END = 410 * MiB;
constexpr size_t SZ_WIN = (size_t)INW * D * 2, SZ_WOUT = (size_t)D * D * 2, SZ_WUP = (size_t)FF * D * 2, SZ_WDN = (size_t)D * FF * 2;
static_assert(WS_WIN + DEPTH * SZ_WIN <= WS_WOUT && WS_WOUT + DEPTH * SZ_WOUT <= WS_WUP && WS_WUP + DEPTH * SZ_WUP <= WS_WDN && WS_WDN + DEPTH * SZ_WDN <= WS_XB, "weights map");
static_assert(WS_XB + (size_t)M * D * 2 <= WS_SSQ && WS_SSQ + (size_t)M * 16 * 4 <= WS_Q && WS_MIX + (size_t)M * D * 2 <= WS_END && WS_HID + (size_t)M * FF * 2 <= WS_END, "activation map");
constexpr int KP = 144, VP = 528;
constexpr int L_K = 0, L_V = 2 * 256 * KP, L_BIAS = L_V + 2 * 64 * VP, L_SSQ = L_BIAS + 8 * 192 * 4, L_END = L_SSQ + 2 * 8 * 32 * 4;
constexpr int LDS_BYTES = 155648;
constexpr int MISC_OFF = LDS_BYTES - 256;
constexpr size_t WS_CTL = 0, CTL_ZERO_BYTES = 16384;
static_assert(L_END <= MISC_OFF && pg8::STAGE_BYTES <= MISC_OFF && XCD_BAR_WORDS * 4 <= (int)CTL_ZERO_BYTES, "LDS map");

__device__ __forceinline__ int tid_opaque() { int t = threadIdx.x; asm volatile("" : "+v"(t)); return t; }
template <int CTRL> __device__ __forceinline__ float dppf(float v) { return __builtin_bit_cast(float, __builtin_amdgcn_update_dpp(0, __builtin_bit_cast(int, v), CTRL, 0xf, 0xf, false)); }
__device__ __forceinline__ float wave_sum(float v) {
    v += dppf<0xB1>(v);
    v += dppf<0x4E>(v);
    v += dppf<0x141>(v);
    v += dppf<0x140>(v);
    const int vi = __builtin_bit_cast(int, v);
    const float r0 = __builtin_bit_cast(float, __builtin_amdgcn_readlane(vi, 0)), r1 = __builtin_bit_cast(float, __builtin_amdgcn_readlane(vi, 16));
    const float r2 = __builtin_bit_cast(float, __builtin_amdgcn_readlane(vi, 32)), r3 = __builtin_bit_cast(float, __builtin_amdgcn_readlane(vi, 48));
    return (r0 + r1) + (r2 + r3);
}
__device__ __forceinline__ unsigned pk2(float lo, float hi) { return pg8::cvt_pk_bf16(lo, hi); }

__device__ __forceinline__ int in_col_map(int n0) {
    if (n0 < 768) { const int pn = n0 >> 8, l = n0 & 255; return (pn << 8) + ((l >> 5) & 1) * 128 + (l >> 6) * 32; }
    if (n0 < 1280) { const int ch = n0 - 768; return ((3 + (ch >> 7)) << 8) + (ch & 127); }
    const int ch = n0 - 1280; return ((3 + (ch >> 7)) << 8) + 128 + (ch & 127);
}
__device__ __forceinline__ void transpose_item(const float* W, int K, int N, bf16* WT, const float* g0, const float* g1, bool inmap, LAS float* scr, int item, int lane, bool stream) {
    const int nblk = N / 32, kb = item / nblk, nb = item % nblk, k0 = 64 * kb, n0 = 32 * nb;
    float wv[32];
#pragma unroll
    for (int i = 0; i < 32; ++i) wv[i] = __builtin_nontemporal_load(W + (size_t)(k0 + 2 * i + (lane >> 5)) * N + n0 + (lane & 31));
#pragma unroll
    for (int i = 0; i < 32; ++i) { const int kk = 2 * i + (lane >> 5), k = k0 + kk; const float g = g0 ? (k < 512 ? g0[k] : g1[k - 512]) : 1.0f;
        scr[kk * 33 + (lane & 31)] = wv[i] * g; }
    asm volatile("s_waitcnt lgkmcnt(0)" ::: "memory");
    const int c = lane & 7, d0 = inmap ? in_col_map(n0) : n0;
    float tv[4][8];
#pragma unroll
    for (int j = 0; j < 4; ++j)
#pragma unroll
        for (int i = 0; i < 8; ++i) tv[j][i] = scr[(8 * c + i) * 33 + (lane >> 3) + 8 * j];
    __builtin_amdgcn_sched_barrier(0);
#pragma unroll
    for (int j = 0; j < 4; ++j) { const int n = (lane >> 3) + 8 * j;
        u32x4 o; o.x = pk2(tv[j][0], tv[j][1]); o.y = pk2(tv[j][2], tv[j][3]); o.z = pk2(tv[j][4], tv[j][5]); o.w = pk2(tv[j][6], tv[j][7]);
        if (stream) __builtin_nontemporal_store(o, (u32x4*)(WT + (size_t)(d0 + n) * K + k0 + 8 * c)); else *(u32x4*)(WT + (size_t)(d0 + n) * K + k0 + 8 * c) = o; }
    asm volatile("s_waitcnt lgkmcnt(0)" ::: "memory");
}

struct Args {
    const float* x; const float* rel_bias; const float* norm_mix_g; const float* w_in; const float* q_norm_g; const float* k_norm_g; const float* sinks;
    const float* conv_w; const float* conv_b; const float* conv_ln_g; const float* conv_ln_b; const float* attn_out_g; const float* conv_out_g; const float* w_out;
    const float* norm_mlp_g; const float* w_mlp_up; const float* w_mlp_down;
    float* out; unsigned char* ws; int ph_lo, ph_hi;
};

__device__ __forceinline__ void convert_layer(const Args& a, LAS unsigned char* lds, int l, int gw, int NGW) {
    const int tid = tid_opaque(), lane = tid & 63, wave = tid >> 6;
    LAS float* scr = (LAS float*)(lds + wave * 16384);
    constexpr int I_IN = (D / 64) * (INW / 32), I_OUT = (D / 64) * (D / 32), I_UP = (D / 64) * (FF / 32), I_DN = (FF / 64) * (D / 32), I_L = I_IN + I_OUT + I_UP + I_DN;
    for (int it = gw; it < I_L; it += NGW) {
        int r = it;
        if (r < I_IN) { transpose_item(a.w_in + (size_t)l * D * INW, D, INW, (bf16*)(a.ws + WS_WIN + l * SZ_WIN), a.norm_mix_g + l * D, a.norm_mix_g + l * D + 512, true, scr, r, lane, l > 0); continue; } r -= I_IN;
        if (r < I_OUT) { transpose_item(a.w_out + (size_t)l * D * D, D, D, (bf16*)(a.ws + WS_WOUT + l * SZ_WOUT), a.attn_out_g + l * 512, a.conv_out_g + l * 512, false, scr, r, lane, l > 0); continue; } r -= I_OUT;
        if (r < I_UP) { transpose_item(a.w_mlp_up + (size_t)l * D * FF, D, FF, (bf16*)(a.ws + WS_WUP + l * SZ_WUP), a.norm_mlp_g + l * D, a.norm_mlp_g + l * D + 512, false, scr, r, lane, l > 0); continue; } r -= I_UP;
        transpose_item(a.w_mlp_down + (size_t)l * FF * D, FF, D, (bf16*)(a.ws + WS_WDN + l * SZ_WDN), nullptr, nullptr, false, scr, r, lane, l > 0);
    }
}
__device__ __forceinline__ void prologue(const Args& a, LAS unsigned char* lds, int vcu, int G) {
    const int tid = tid_opaque(), lane = tid & 63, wave = tid >> 6;
    const int gw = vcu * 8 + wave, NGW = G * 8;
    convert_layer(a, lds, 0, gw, NGW);
    bf16* xb = (bf16*)(a.ws + WS_XB); float* ssq = (float*)(a.ws + WS_SSQ);
    const int rpb = M / G, rbase = vcu * rpb;
    for (int m0 = rbase + wave * 4; m0 < rbase + rpb; m0 += 32) {
        f32x4 v[4][4]; float s[4];
#pragma unroll
        for (int q = 0; q < 4; ++q) { const f32x4* xr = (const f32x4*)(a.x + (size_t)(m0 + q) * D) + lane;
#pragma unroll
            for (int j = 0; j < 4; ++j) v[q][j] = __builtin_nontemporal_load(xr + 64 * j); }
#pragma unroll
        for (int q = 0; q < 4; ++q) { float t = 0.f;
#pragma unroll
            for (int j = 0; j < 4; ++j) t += (v[q][j][0] * v[q][j][0] + v[q][j][1] * v[q][j][1]) + (v[q][j][2] * v[q][j][2] + v[q][j][3] * v[q][j][3]);
            s[q] = wave_sum(t); }
#pragma unroll
        for (int q = 0; q < 4; ++q) { u32x2* o8 = (u32x2*)(xb + (size_t)(m0 + q) * D) + lane;
#pragma unroll
            for (int j = 0; j < 4; ++j) { u32x2 w; w.x = pk2(v[q][j][0], v[q][j][1]); w.y = pk2(v[q][j][2], v[q][j][3]); o8[64 * j] = w; } }
        { const int q = lane >> 4, c = lane & 15; const float sq = q == 0 ? s[0] : q == 1 ? s[1] : q == 2 ? s[2] : s[3]; ssq[(size_t)(m0 + q) * 16 + c] = c == 0 ? sq : 0.f; }
    }
}

__device__ __forceinline__ void attn_bias_table(LAS unsigned char* lds, const float* rel_bias) {
    LAS float* bt = (LAS float*)(lds + L_BIAS);
    for (int i = tid_opaque(); i < 8 * 192; i += 512) { const int h = i / 192, dist = 159 - i % 192; float v = 0.f;
        if (dist >= 0 && dist < 128) { int bk = dist; if (dist >= 16) { bk = 16 + (int)(__log2f((float)dist * 0.0625f) * (16.0f / 3.0f)); bk = bk < 31 ? bk : 31; } v = rel_bias[bk * 8 + h] * LOG2E; }
        bt[i] = v; }
}
__device__ __forceinline__ void attn_stage(LAS unsigned char* lds, int b, int qb, const bf16* Kb, const bf16* Vg) {
    const int tid = tid_opaque(), tok0 = qb * 128 - 128;
#pragma unroll
    for (int it = 0; it < 8; ++it) { const int c = it * 512 + tid, kb = c >> 4, sub = c & 15, tok = tok0 + kb;
        u32x4 v = (u32x4){0u, 0u, 0u, 0u}; if (tok >= 0) v = *(const u32x4*)(Kb + ((size_t)b * T + tok) * 128 + sub * 8);
        *(LAS u32x4*)(lds + L_K + (sub >> 3) * 256 * KP + kb * KP + (sub & 7) * 16) = v; }
#pragma unroll
    for (int it = 0; it < 8; ++it) { const int c = it * 512 + tid, kb = c & 255, grp = c >> 8, tok = tok0 + kb;
        u32x4 v = (u32x4){0u, 0u, 0u, 0u}; if (tok >= 0) v = *(const u32x4*)(Vg + ((size_t)(b * 16 + grp) * T + tok) * 8);
        const int pos = (kb & ~12) | ((kb & 4) << 1) | ((kb & 8) >> 1);
        LAS unsigned short* d = (LAS unsigned short*)(lds + L_V + (grp >> 3) * 64 * VP + (grp & 7) * 8 * VP + pos * 2);
        d[0 * (VP / 2)] = (unsigned short)(v.x & 0xffffu); d[1 * (VP / 2)] = (unsigned short)(v.x >> 16);
        d[2 * (VP / 2)] = (unsigned short)(v.y & 0xffffu); d[3 * (VP / 2)] = (unsigned short)(v.y >> 16);
        d[4 * (VP / 2)] = (unsigned short)(v.z & 0xffffu); d[5 * (VP / 2)] = (unsigned short)(v.z >> 16);
        d[6 * (VP / 2)] = (unsigned short)(v.w & 0xffffu); d[7 * (VP / 2)] = (unsigned short)(v.w >> 16); }
}
__device__ __forceinline__ void attn_compute(LAS unsigned char* lds, int b, int qb, const bf16* Q, bf16* mix, const float* sinks_l) {
    const int tid = tid_opaque(), lane = tid & 63, r32 = lane & 31, hi = lane >> 5;
    const int h = __builtin_amdgcn_readfirstlane(tid >> 6), kvh = h >> 2;
    const LAS float* bR = (const LAS float*)(lds + L_BIAS) + h * 192 + 31 - (r32 - 4 * hi);
    const LAS unsigned char* Kl = lds + L_K + kvh * 256 * KP + r32 * KP + hi * 16;
    const LAS unsigned char* Vl = lds + L_V + kvh * 64 * VP + r32 * VP + hi * 16;
    const size_t rowbase = (size_t)b * T + (size_t)qb * 128;
    const int jmin = (qb == 0) ? 4 : 0;
    const float sink2 = sinks_l[h] * LOG2E;
    const bf16* qp = Q + (rowbase + r32) * 512 + h * 64 + hi * 8;
    bf16x8 qn[4];
#pragma unroll
    for (int ds = 0; ds < 4; ++ds) qn[ds] = *(const bf16x8*)(qp + ds * 16);
#pragma unroll 1
    for (int rb = 0; rb < 4; ++rb) {
        bf16x8 qf[4];
#pragma unroll
        for (int ds = 0; ds < 4; ++ds) qf[ds] = qn[ds];
        if (rb < 3) {
#pragma unroll
            for (int ds = 0; ds < 4; ++ds) qn[ds] = *(const bf16x8*)(qp + (size_t)(rb + 1) * 32 * 512 + ds * 16);
        }
        f32x16 s[5];
        bf16x8 kf[2][4];
#pragma unroll
        for (int ds = 0; ds < 4; ++ds) kf[0][ds] = *(const LAS bf16x8*)(Kl + (32 * rb) * KP + ds * 32);
#pragma unroll
        for (int j = 0; j < 5; ++j) {
            if (j < 4) {
#pragma unroll
                for (int ds = 0; ds < 4; ++ds) kf[(j + 1) & 1][ds] = *(const LAS bf16x8*)(Kl + (32 * (rb + j + 1)) * KP + ds * 32);
            }
            __builtin_amdgcn_sched_barrier(0);
            const float s0 = ((rb + j) >= jmin) ? 0.f : -1e30f;
#pragma unroll
            for (int r = 0; r < 16; ++r) s[j][r] = s0;
#pragma unroll
            for (int ds = 0; ds < 4; ++ds) s[j] = __builtin_amdgcn_mfma_f32_32x32x16_bf16(kf[j & 1][ds], qf[ds], s[j], 0, 0, 0);
            __builtin_amdgcn_sched_barrier(0);
        }
        float mx = sink2;
        const int tq = r32 - 4 * hi;
        f32x2 sv[5][8];
        f32x2 bz[2][8];
#pragma unroll
        for (int r2 = 0; r2 < 8; ++r2) { const int kc = ((2 * r2) & 3) + 8 * ((2 * r2) >> 2); bz[0][r2] = (f32x2){bR[kc], bR[kc + 1]}; }
#pragma unroll
        for (int j = 0; j < 5; ++j) {
            if (j < 4) {
#pragma unroll
                for (int r2 = 0; r2 < 8; ++r2) { const int kc = ((2 * r2) & 3) + 8 * ((2 * r2) >> 2); bz[(j + 1) & 1][r2] = (f32x2){bR[32 * (j + 1) + kc], bR[32 * (j + 1) + kc + 1]}; }
            }
            __builtin_amdgcn_sched_barrier(0);
#pragma unroll
            for (int r2 = 0; r2 < 8; ++r2) { const int r = 2 * r2, kc = (r & 3) + 8 * (r >> 2);
                f32x2 v = (f32x2){s[j][r], s[j][r + 1]} + bz[j & 1][r2];
                if (j == 0) v += (f32x2){(kc > tq) ? 0.f : -1e30f, (kc + 1 > tq) ? 0.f : -1e30f};
                if (j == 4) v += (f32x2){(kc <= tq) ? 0.f : -1e30f, (kc + 1 <= tq) ? 0.f : -1e30f};
                sv[j][r2] = v; mx = fmaxf(mx, fmaxf(v[0], v[1])); }
            __builtin_amdgcn_sched_barrier(0);
        }
        { const auto sw = __builtin_amdgcn_permlane32_swap(__float_as_uint(mx), __float_as_uint(mx), false, false); mx = fmaxf(__uint_as_float(sw[0]), __uint_as_float(sw[1])); }
        f32x2 l2 = (f32x2){0.f, 0.f}; const f32x2 mx2 = (f32x2){mx, mx};
        f32x16 o[2];
#pragma unroll
        for (int r = 0; r < 16; ++r) { o[0][r] = 0.f; o[1][r] = 0.f; }
        bf16x8 vf[2][4];
#pragma unroll
        for (int q = 0; q < 4; ++q) vf[0][q] = *(const LAS bf16x8*)(Vl + (q & 1) * 32 * VP + (32 * rb + 16 * (q >> 1)) * 2);
#pragma unroll
        for (int j = 0; j < 5; ++j) {
            if (j < 4) {
#pragma unroll
                for (int q = 0; q < 4; ++q) vf[(j + 1) & 1][q] = *(const LAS bf16x8*)(Vl + (q & 1) * 32 * VP + (32 * (rb + j + 1) + 16 * (q >> 1)) * 2);
            }
            __builtin_amdgcn_sched_barrier(0);
#pragma unroll
            for (int r2 = 0; r2 < 8; ++r2) { const f32x2 d = sv[j][r2] - mx2; f32x2 p; p[0] = __builtin_amdgcn_exp2f(d[0]); p[1] = __builtin_amdgcn_exp2f(d[1]); sv[j][r2] = p; l2 += p; }
#pragma unroll
            for (int sh = 0; sh < 2; ++sh) {
                u32x4 pw; pw.x = pk2(sv[j][4 * sh + 0][0], sv[j][4 * sh + 0][1]); pw.y = pk2(sv[j][4 * sh + 1][0], sv[j][4 * sh + 1][1]); pw.z = pk2(sv[j][4 * sh + 2][0], sv[j][4 * sh + 2][1]); pw.w = pk2(sv[j][4 * sh + 3][0], sv[j][4 * sh + 3][1]);
                const bf16x8 pf = __builtin_bit_cast(bf16x8, pw);
#pragma unroll
                for (int dt = 0; dt < 2; ++dt) o[dt] = __builtin_amdgcn_mfma_f32_32x32x16_bf16(vf[j & 1][sh * 2 + dt], pf, o[dt], 0, 0, 0);
            }
            __builtin_amdgcn_sched_barrier(0);
        }
        float l = l2[0] + l2[1];
        { const auto sw = __builtin_amdgcn_permlane32_swap(__float_as_uint(l), __float_as_uint(l), false, false); l = __uint_as_float(sw[0]) + __uint_as_float(sw[1]); }
        l += __builtin_amdgcn_exp2f(sink2 - mx);
        const float inv = __builtin_amdgcn_rcpf(l);
        f32x2 ov[2][8]; f32x2 ss2 = (f32x2){0.f, 0.f}; const f32x2 inv2 = (f32x2){inv, inv};
#pragma unroll
        for (int dt = 0; dt < 2; ++dt)
#pragma unroll
            for (int r2 = 0; r2 < 8; ++r2) { ov[dt][r2] = (f32x2){o[dt][2 * r2], o[dt][2 * r2 + 1]} * inv2; ss2 += ov[dt][r2] * ov[dt][r2]; }
        float ss = ss2[0] + ss2[1];
        { const auto sw = __builtin_amdgcn_permlane32_swap(__float_as_uint(ss), __float_as_uint(ss), false, false); ss = __uint_as_float(sw[0]) + __uint_as_float(sw[1]); }
        LAS float* X = (LAS float*)(lds + L_SSQ) + (rb & 1) * 256;
        if (hi == 0) X[h * 32 + r32] = ss;
        __syncthreads();
        float tot = 0.f;
#pragma unroll
        for (int hh = 0; hh < 8; ++hh) tot += X[hh * 32 + r32];
        const float rr = rsqrtf(tot * (1.0f / 512.0f) + EPS);
        bf16* op = mix + (rowbase + rb * 32 + r32) * 1024 + h * 64 + 8 * hi;
        const f32x2 rr2 = (f32x2){rr, rr};
#pragma unroll
        for (int dt = 0; dt < 2; ++dt)
#pragma unroll
            for (int k = 0; k < 4; k += 2) {
                const f32x2 a0 = ov[dt][2 * k] * rr2, a1 = ov[dt][2 * k + 1] * rr2, b0 = ov[dt][2 * k + 2] * rr2, b1 = ov[dt][2 * k + 3] * rr2;
                unsigned ax = pk2(a0[0], a0[1]), ay = pk2(a1[0], a1[1]), bx_ = pk2(b0[0], b0[1]), by = pk2(b1[0], b1[1]);
                { const auto r = __builtin_amdgcn_permlane32_swap(ax, bx_, false, false); ax = r[0]; bx_ = r[1]; }
                { const auto r = __builtin_amdgcn_permlane32_swap(ay, by, false, false); ay = r[0]; by = r[1]; }
                u32x4 w; w.x = ax; w.y = ay; w.z = bx_; w.w = by;
                *(u32x4*)(op + dt * 32 + 8 * k) = w; }
    }
}

constexpr int CT = 16, CWIN = CT + 30, CITEM = 2 * CT;
template <int S> __device__ __forceinline__ unsigned conv_ld(const bf16* hp, int tt) {
    unsigned hv = 0u; if (S >= 30 || tt - 30 + S >= 0) hv = *(const unsigned*)(hp + (long)S * 512); return hv;
}
template <int S> __device__ __forceinline__ void conv_fma(f32x2 (&acc)[CT], const f32x2 (&w)[31], unsigned hv) {
    f32x2 hf; hf[0] = __uint_as_float(hv << 16); hf[1] = __uint_as_float(hv & 0xffff0000u);
#pragma unroll
    for (int j = 0; j < 31; ++j) { const int tok = S - j; if (tok >= 0 && tok < CT) acc[tok] += w[j] * hf; }
}
template <int... I> __device__ __forceinline__ void conv_load_all(std::integer_sequence<int, I...>, unsigned (&hv)[CWIN], const bf16* hp, int tt) { ((hv[I] = conv_ld<I>(hp, tt)), ...); }
template <int... I> __device__ __forceinline__ void conv_fma_all(std::integer_sequence<int, I...>, f32x2 (&acc)[CT], const f32x2 (&w)[31], const unsigned (&hv)[CWIN]) { (conv_fma<I>(acc, w, hv[I]), ...); }
__device__ __forceinline__ void conv_weights(f32x2 (&w)[31], f32x2& bias, const float* cw, const float* cb) {
    const int cp = tid_opaque() & 255;
#pragma unroll
    for (int j = 0; j < 31; ++j) w[j] = *(const f32x2*)(cw + j * 512 + 2 * cp);
    bias = *(const f32x2*)(cb + 2 * cp);
}
__device__ __forceinline__ void conv_phase(LAS unsigned char* lds, int bx, int G, const bf16* Hg, const float* cw, const float* cb, const float* lg, const float* lb, bf16* mix) {
    const int tid = tid_opaque(), cp = tid & 255, half = tid >> 8, lane = tid & 63, wave = tid >> 6;
    constexpr int NIT = M / CITEM;
    f32x2 w[31]; f32x2 bias; conv_weights(w, bias, cw, cb);
    const f32x4 g0 = *(const f32x4*)(lg + lane * 8), g1 = *(const f32x4*)(lg + lane * 8 + 4), b0 = *(const f32x4*)(lb + lane * 8), b1 = *(const f32x4*)(lb + lane * 8 + 4);
    unsigned hv[CWIN];
    const int per = (NIT + G - 1) / G, itend = (bx + 1) * per < NIT ? (bx + 1) * per : NIT;
    int it = bx * per, par = 0;
    if (it < itend) { const int ts = it * CITEM + half * CT; conv_load_all(std::make_integer_sequence<int, CWIN>{}, hv, Hg + ((long)ts - 30) * 512 + 2 * cp, ts & (T - 1)); }
#pragma unroll 1
    for (; it < itend; ++it, par ^= 1) {
        f32x2 acc[CT];
#pragma unroll
        for (int k = 0; k < CT; ++k) acc[k] = bias;
        conv_fma_all(std::make_integer_sequence<int, CWIN>{}, acc, w, hv);
        LAS float* Y = (LAS float*)lds + par * (CITEM * 512);
#pragma unroll
        for (int k = 0; k < CT; ++k) *(LAS f32x2*)(Y + (half * CT + k) * 512 + 2 * cp) = acc[k];
        { const int nit = it + 1; if (nit < itend) { const int ts = nit * CITEM + half * CT; conv_load_all(std::make_integer_sequence<int, CWIN>{}, hv, Hg + ((long)ts - 30) * 512 + 2 * cp, ts & (T - 1)); } }
        __syncthreads();
        constexpr int NT = CITEM / 8;
        f32x4 y0[NT], y1[NT]; float red[NT];
#pragma unroll
        for (int k = 0; k < NT; ++k) { const int tok = wave * NT + k; y0[k] = *(const LAS f32x4*)(Y + tok * 512 + lane * 8); y1[k] = *(const LAS f32x4*)(Y + tok * 512 + lane * 8 + 4); }
#pragma unroll
        for (int k = 0; k < NT; ++k) red[k] = ((y0[k][0] + y0[k][1]) + (y0[k][2] + y0[k][3])) + ((y1[k][0] + y1[k][1]) + (y1[k][2] + y1[k][3]));
#pragma unroll
        for (int k = 0; k < NT; ++k) red[k] = wave_sum(red[k]) * (1.0f / 512.0f);
#pragma unroll
        for (int k = 0; k < NT; ++k) { y0[k] = y0[k] - red[k]; y1[k] = y1[k] - red[k]; const f32x4 q0 = y0[k] * y0[k], q1 = y1[k] * y1[k]; red[k] = ((q0[0] + q0[1]) + (q0[2] + q0[3])) + ((q1[0] + q1[1]) + (q1[2] + q1[3])); }
#pragma unroll
        for (int k = 0; k < NT; ++k) red[k] = rsqrtf(wave_sum(red[k]) * (1.0f / 512.0f) + EPS);
#pragma unroll
        for (int k = 0; k < NT; ++k) { y0[k] = y0[k] * red[k] * g0 + b0; y1[k] = y1[k] * red[k] * g1 + b1; float ss = 0.f;
#pragma unroll
            for (int i = 0; i < 4; ++i) { y0[k][i] = y0[k][i] * __builtin_amdgcn_rcpf(1.0f + __expf(-y0[k][i])); y1[k][i] = y1[k][i] * __builtin_amdgcn_rcpf(1.0f + __expf(-y1[k][i])); ss += y0[k][i] * y0[k][i] + y1[k][i] * y1[k][i]; }
            red[k] = ss; }
#pragma unroll
        for (int k = 0; k < NT; ++k) red[k] = rsqrtf(wave_sum(red[k]) * (1.0f / 512.0f) + EPS);
#pragma unroll
        for (int k = 0; k < NT; ++k) { const int tok = wave * NT + k; const float rr = red[k];
            u32x4 o; o.x = pk2(y0[k][0] * rr, y0[k][1] * rr); o.y = pk2(y0[k][2] * rr, y0[k][3] * rr); o.z = pk2(y1[k][0] * rr, y1[k][1] * rr); o.w = pk2(y1[k][2] * rr, y1[k][3] * rr);
            *(u32x4*)(mix + ((size_t)it * CITEM + tok) * 1024 + 512 + lane * 8) = o; }
    }
    __syncthreads();
}

#ifndef MK_N_LAUNCHES
#define MK_N_LAUNCHES 1
#endif
#ifndef MLP_SPLIT
#define MLP_SPLIT 2
#endif
constexpr int PPL = 3 + 2 * MLP_SPLIT, NPHASE = 1 + PPL * DEPTH;
__global__ void __launch_bounds__(512, 2) fwd_kernel(Args a) {
    extern __shared__ __attribute__((aligned(16))) unsigned char lds_raw[];
    LAS unsigned char* lds = (LAS unsigned char*)lds_raw;
    cg::grid_group grid = cg::this_grid();
    const int G = gridDim.x, bx = blockIdx.x, vcu = (G % 8 == 0) ? (bx % 8) * (G / 8) + bx / 8 : bx;
    const int lo = a.ph_lo, hi = a.ph_hi;
#define IN(k) (lo <= (k) && (k) < hi)
    volatile LAS unsigned* MISC = (volatile LAS unsigned*)(lds + MISC_OFF);
    if (threadIdx.x < 64) MISC[threadIdx.x] = 0u;
    __syncthreads();
    XcdBarrier bar; bar.bar = (unsigned*)(a.ws + WS_CTL); bar.x = 0; bar.st = nullptr;
    if (hi - lo > 1) bar = xcd_barrier_post((unsigned*)(a.ws + WS_CTL), MISC + 8);
    if (lo < 0) grid.sync();
#define SEAM(k) do { if ((k) + 1 < hi) xcd_barrier(bar); } while (0)
    bf16* xb = (bf16*)(a.ws + WS_XB); float* ssq = (float*)(a.ws + WS_SSQ);
    bf16* Qb = (bf16*)(a.ws + WS_Q); bf16* Kb = (bf16*)(a.ws + WS_K); bf16* Vg = (bf16*)(a.ws + WS_V); bf16* Hg = (bf16*)(a.ws + WS_HG); bf16* mix = (bf16*)(a.ws + WS_MIX); bf16* hid = (bf16*)(a.ws + WS_HID);
    if (IN(0)) { prologue(a, lds, vcu, G); __syncthreads(); SEAM(0); }
#pragma unroll 1
    for (int l = 0; l < DEPTH; ++l) {
        const int k0 = 1 + PPL * l;
        if (IN(k0)) {
            pg8::Gemm g{xb, (const bf16*)(a.ws + WS_WIN + l * SZ_WIN), M, INW, D}; pg8::StaticOrder S; S.init(M, INW, G, bx);
            pg8::EpiIn E{ssq, a.q_norm_g + l * 64, a.k_norm_g + l * 64, Qb, Kb, Vg, Hg};
            pg8::gemm_phase<pg8::EpiIn, pg8::StaticOrder, true, true, true>(lds, g, S, E);
            if (l + 1 < DEPTH) {
                constexpr int NU = (M / 256) * (INW / 256); const int rounds = (NU + G - 1) / G, nlast = NU - (rounds - 1) * G, first = (nlast >= G) ? 0 : nlast;
                if (bx >= first) convert_layer(a, lds, l + 1, (bx - first) * 8 + (tid_opaque() >> 6), (G - first) * 8);
            }
            SEAM(k0);
        }
        if (IN(k0 + 1)) {
            attn_bias_table(lds, a.rel_bias);
            for (int it = vcu; it < NB * (T / 128); it += G) { const int b = it / (T / 128), qb = it % (T / 128);
                __syncthreads(); attn_stage(lds, b, qb, Kb, Vg); __syncthreads();
                attn_compute(lds, b, qb, Qb, mix, a.sinks + l * 8); }
            __syncthreads();
            conv_phase(lds, vcu, G, Hg, a.conv_w + (size_t)l * 31 * 512, a.conv_b + l * 512, a.conv_ln_g + l * 512, a.conv_ln_b + l * 512, mix);
            SEAM(k0 + 1);
        }
        if (IN(k0 + 2)) {
            pg8::Gemm g{mix, (const bf16*)(a.ws + WS_WOUT + l * SZ_WOUT), M, D, D}; pg8::StaticOrder S; S.init(M, D, G, bx);
#if RES_BF16
            pg8::EpiRes E{nullptr, nullptr, xb, ssq};
#else
            pg8::EpiRes E{l == 0 ? a.x : a.out, a.out, xb, ssq};
#endif
            pg8::gemm_phase<pg8::EpiRes, pg8::StaticOrder, true, true, true>(lds, g, S, E);
            SEAM(k0 + 2);
        }
#pragma unroll 1
        for (int hf = 0; hf < MLP_SPLIT; ++hf) {
            constexpr int MS = M / MLP_SPLIT; const size_t r0 = (size_t)hf * MS;
            const int ku = k0 + 3 + 2 * hf, kd = ku + 1;
            if (IN(ku)) {
                pg8::Gemm g{xb + r0 * D, (const bf16*)(a.ws + WS_WUP + l * SZ_WUP), MS, FF, D}; pg8::StaticOrder S; S.init(MS, FF, G, bx);
                pg8::EpiUp E{ssq + r0 * 16, hid};
                pg8::gemm_phase<pg8::EpiUp, pg8::StaticOrder, true, true, true>(lds, g, S, E);
                SEAM(ku);
            }
            if (IN(kd)) {
                pg8::Gemm g{hid, (const bf16*)(a.ws + WS_WDN + l * SZ_WDN), MS, D, FF}; pg8::StaticOrder S; S.init(MS, D, G, bx);
#if RES_BF16
                pg8::EpiRes E{nullptr, l == DEPTH - 1 ? a.out + r0 * D : nullptr, xb + r0 * D, ssq + r0 * 16};
#else
                pg8::EpiRes E{a.out + r0 * D, a.out + r0 * D, xb + r0 * D, ssq + r0 * 16};
#endif
                pg8::gemm_phase<pg8::EpiRes, pg8::StaticOrder, true, true, true>(lds, g, S, E);
                SEAM(kd);
            }
        }
    }
#undef IN
#undef SEAM
}

extern "C" void kernel_launch(void* const* d_in, const int* in_sizes, int n_in, void* d_out, int out_size, void* d_ws, size_t ws_size, hipStream_t stream) {
    static int grid = 0;
    if (grid == 0) {
        if (n_in != 17 || in_sizes[0] != M * D || out_size != M * D || ws_size < WS_END) { fprintf(stderr, "kernel_launch: unexpected shapes (n_in %d, in0 %d, out %d, ws %zu); nothing launched\n", n_in, n_in > 0 ? in_sizes[0] : -1, out_size, ws_size); grid = -1; return; }
        int dev = 0, cus = 0, per_cu = 0;
        if (hipGetDevice(&dev) != hipSuccess || hipDeviceGetAttribute(&cus, hipDeviceAttributeMultiprocessorCount, dev) != hipSuccess) { grid = -1; return; }
        if (hipFuncSetAttribute((const void*)fwd_kernel, hipFuncAttributeMaxDynamicSharedMemorySize, LDS_BYTES) != hipSuccess) { fprintf(stderr, "kernel_launch: hipFuncSetAttribute failed\n"); grid = -1; return; }
        if (hipOccupancyMaxActiveBlocksPerMultiprocessor(&per_cu, (const void*)fwd_kernel, 512, LDS_BYTES) != hipSuccess || per_cu < 1) { fprintf(stderr, "kernel_launch: occupancy query says %d\n", per_cu); per_cu = 1; }
        (void)hipGetLastError();
        grid = cus * per_cu;
        if (M % grid != 0 || (M / grid) % 32 != 0) { fprintf(stderr, "kernel_launch: grid %d does not divide the rows into 32-row multiples; nothing launched\n", grid); grid = -1; return; }
    }
    if (grid < 0) return;
    Args a{};
    const float** p = (const float**)&a;
    for (int i = 0; i < 17; ++i) p[i] = (const float*)d_in[i];
    a.out = (float*)d_out; a.ws = (unsigned char*)d_ws;
#if MK_N_LAUNCHES == 1
    if (hipMemsetAsync((char*)d_ws + WS_CTL, 0, CTL_ZERO_BYTES, stream) != hipSuccess) { fprintf(stderr, "kernel_launch: memset of the barrier words failed\n"); return; }
    a.ph_lo = 0; a.ph_hi = NPHASE;
    void* args[] = {&a};
    hipError_t e = hipLaunchCooperativeKernel((const void*)fwd_kernel, dim3(grid), dim3(512), args, LDS_BYTES, stream);
    if (e != hipSuccess) fprintf(stderr, "kernel_launch: cooperative launch failed: %s (grid %d)\n", hipGetErrorString(e), grid);
#else
    for (int ph = 0; ph < NPHASE; ++ph) { a.ph_lo = ph; a.ph_hi = ph + 1; hipLaunchKernelGGL(fwd_kernel, dim3(grid), dim3(512), LDS_BYTES, stream, a); }
#endif
}
```

```cpp
#include <hip/hip_runtime.h>
#include <hip/hip_cooperative_groups.h>
#include <cstdio>
#include <cstdint>
#include <utility>
namespace cg = cooperative_groups;
namespace pg8 {
#define PG8_LAS __attribute__((address_space(3)))
typedef unsigned short bf16_t;
typedef short bf16x8 __attribute__((ext_vector_type(8)));
typedef float f32x4 __attribute__((ext_vector_type(4)));
typedef unsigned u32x4 __attribute__((ext_vector_type(4)));
constexpr int BM = 256, BK = 64, HALF = 128, HTB = HALF * BK * 2  , STAGE_BYTES = 8 * HTB, NXCD = 8, WGM = 8;

__host__ __device__ __forceinline__ int lds_byte(int r, int c) { const int st = (r >> 4) * 2 + (c >> 5), rr = r & 15, cc = c & 31, ob = rr * 64 + cc * 2; return st * 1024 + (ob ^ (((ob >> 9) & 1) << 5)); }
__host__ __device__ __forceinline__ void stage_rc(int b, int& R, int& C) { const int st = b / 1024, sb = b % 1024, swz = sb ^ (((sb >> 9) & 1) << 5); R = (st >> 1) * 16 + swz / 64; C = (st & 1) * 32 + (swz % 64) / 2; }
__host__ __device__ __forceinline__ int perm32(int rho) { const int n = rho >> 4, i = rho & 15; return 8 * (i >> 2) + 4 * n + (i & 3); }

struct Unit { int pm, pn; };
struct Gemm { const bf16_t* A; const bf16_t* Bt; int M, N, K; };

struct StaticOrder {
    int nM, nN, nwg, G, c;
    __host__ __device__ void init(int M, int N, int G_, int c_) { nM = M / BM; nN = N / BM; nwg = nM * nN; G = G_; c = c_; }
    __host__ __device__ bool next(int i, Unit& u) const {
        const long L = (long)i * G + c; if (L >= nwg) return false;
        int wgid = (int)L; { const int q = nwg / NXCD, r = nwg % NXCD, xcd = wgid % NXCD, off = wgid / NXCD; wgid = (xcd < r ? xcd * (q + 1) : r * (q + 1) + (xcd - r) * q) + off; }
        const int nig = WGM * nN, gid = wgid / nig, fm = gid * WGM, gsz = (nM - fm) < WGM ? (nM - fm) : WGM;
        u.pm = fm + ((wgid % nig) % gsz); u.pn = (wgid % nig) / gsz; return true;
    }
    __device__ __forceinline__ void a_ready(const Unit&) const {}
    __device__ __forceinline__ void done(const Unit&) const {}
};

__device__ __forceinline__ unsigned cvt_pk_bf16(float lo, float hi) { unsigned r; asm volatile("v_cvt_pk_bf16_f32 %0, %1, %2" : "=v"(r) : "v"(lo), "v"(hi)); return r; }
typedef float f32x2 __attribute__((ext_vector_type(2)));
constexpr float EPS_ = 1e-6f;
constexpr int TT = 8192;
constexpr float QSCALE = 0.125f * 1.4426950408889634f;
__device__ __forceinline__ float xsum4(float s) {
    const auto a = __builtin_amdgcn_permlane16_swap(__float_as_uint(s), __float_as_uint(s), false, false); s = __uint_as_float(a[0]) + __uint_as_float(a[1]);
    const auto b = __builtin_amdgcn_permlane32_swap(__float_as_uint(s), __float_as_uint(s), false, false); return __uint_as_float(b[0]) + __uint_as_float(b[1]);
}
__device__ __forceinline__ float row_rstd(const float* ssq, int row, int fq) {
    const f32x4 p = *(const f32x4*)(ssq + (size_t)row * 16 + fq * 4);
    float s = (p[0] + p[1]) + (p[2] + p[3]); s = xsum4(s);
    return rsqrtf(s * (1.0f / 1024.0f) + EPS_);
}
__device__ __forceinline__ u32x4 pack8(const f32x4 a, const f32x4 b) { u32x4 w; w.x = cvt_pk_bf16(a[0], a[1]); w.y = cvt_pk_bf16(a[2], a[3]); w.z = cvt_pk_bf16(b[0], b[1]); w.w = cvt_pk_bf16(b[2], b[3]); return w; }

__device__ __forceinline__ void zero_acc(f32x4 (&acc)[2][2][4][2]) {
#pragma unroll
    for (int a = 0; a < 2; ++a)
#pragma unroll
        for (int b = 0; b < 2; ++b)
#pragma unroll
            for (int m = 0; m < 4; ++m)
#pragma unroll
                for (int n = 0; n < 2; ++n) acc[a][b][m][n] = (f32x4){0.f, 0.f, 0.f, 0.f};
}
struct EpiIn {
    static constexpr bool PERM = true, AFTER_DRAIN = false;
    const float* ssq; const float* qg; const float* kg;
    bf16_t* Q; bf16_t* Kb; bf16_t* Vg; bf16_t* Hg;
    __device__ __forceinline__ void init(f32x4 (&acc)[2][2][4][2], const Unit&, int, int, int, int) const { zero_acc(acc); }
    __device__ __forceinline__ void operator()(const f32x4 (&acc)[2][2][4][2], const Unit& u, int wr, int wc, int fr, int fq) const {
        const int pn = u.pn;
        float rsv[2][4];
        { f32x4 pv[2][4];
#pragma unroll
          for (int ai = 0; ai < 2; ++ai)
#pragma unroll
              for (int m = 0; m < 4; ++m) pv[ai][m] = *(const f32x4*)(ssq + (size_t)(u.pm * BM + ai * HALF + wr * 64 + m * 16 + fr) * 16 + fq * 4);
          __builtin_amdgcn_sched_barrier(0);
#pragma unroll
          for (int ai = 0; ai < 2; ++ai)
#pragma unroll
              for (int m = 0; m < 4; ++m) { const f32x4 p = pv[ai][m]; rsv[ai][m] = rsqrtf(xsum4((p[0] + p[1]) + (p[2] + p[3])) * (1.0f / 1024.0f) + EPS_); } }
        if (pn >= 3) {
#pragma unroll
            for (int ai = 0; ai < 2; ++ai)
#pragma unroll
                for (int m = 0; m < 4; ++m) {
                    const int row = u.pm * BM + ai * HALF + wr * 64 + m * 16 + fr; const float rs = rsv[ai][m];
                    f32x4 h[2];
#pragma unroll
                    for (int n = 0; n < 2; ++n)
#pragma unroll
                        for (int i = 0; i < 4; ++i) { const float uu = acc[ai][0][m][n][i] * rs, gg = acc[ai][1][m][n][i] * rs; h[n][i] = uu * __builtin_amdgcn_rcpf(1.0f + __expf(-gg)); }
                    *(u32x4*)(Hg + (size_t)row * 512 + (pn - 3) * 128 + wc * 32 + fq * 8) = pack8(h[0], h[1]);
                }
        } else if (pn < 2 || wc < 2) {
            const bool isq = pn < 2; const float* g = isq ? qg : kg; const float osc = isq ? QSCALE : 1.0f;
            bf16_t* base = isq ? Q + (pn * 4 + wc) * 64 : Kb + wc * 64; const int ld = isq ? 512 : 128;
            f32x4 gv[2][2];
#pragma unroll
            for (int bj = 0; bj < 2; ++bj)
#pragma unroll
                for (int n = 0; n < 2; ++n) gv[bj][n] = *(const f32x4*)(g + bj * 32 + fq * 8 + n * 4);
#pragma unroll
            for (int ai = 0; ai < 2; ++ai)
#pragma unroll
                for (int m = 0; m < 4; ++m) {
                    const int row = u.pm * BM + ai * HALF + wr * 64 + m * 16 + fr; const float rs = rsv[ai][m];
                    f32x4 v[2][2]; float ss = 0.f;
#pragma unroll
                    for (int bj = 0; bj < 2; ++bj)
#pragma unroll
                        for (int n = 0; n < 2; ++n) { v[bj][n] = acc[ai][bj][m][n] * rs; const f32x4 q = v[bj][n] * v[bj][n]; ss += (q[0] + q[1]) + (q[2] + q[3]); }
                    ss = xsum4(ss); const float r = rsqrtf(ss * (1.0f / 64.0f) + EPS_) * osc;
#pragma unroll
                    for (int bj = 0; bj < 2; ++bj) *(u32x4*)(base + (size_t)row * ld + bj * 32 + fq * 8) = pack8(v[bj][0] * gv[bj][0] * r, v[bj][1] * gv[bj][1] * r);
                }
        } else {
            const int kvh = wc - 2;
#pragma unroll
            for (int ai = 0; ai < 2; ++ai)
#pragma unroll
                for (int m = 0; m < 4; ++m) {
                    const int row = u.pm * BM + ai * HALF + wr * 64 + m * 16 + fr; const float rs = rsv[ai][m];
                    const int b = row / TT, t = row % TT;
#pragma unroll
                    for (int bj = 0; bj < 2; ++bj) { const int dc = bj * 4 + fq;
                        *(u32x4*)(Vg + ((size_t)((b * 2 + kvh) * 8 + dc) * TT + t) * 8) = pack8(acc[ai][bj][m][0] * rs, acc[ai][bj][m][1] * rs); }
                }
        }
    }
};
#ifndef RES_BF16
#define RES_BF16 1
#endif
struct EpiRes {
    static constexpr bool PERM = true, AFTER_DRAIN = false;
    const float* resid; float* xout; bf16_t* xb; float* ssq; bool feed;
    __device__ __forceinline__ void init(f32x4 (&acc)[2][2][4][2], const Unit& u, int wr, int wc, int fr, int fq) const {
        if (resid) {
#pragma unroll
            for (int ai = 0; ai < 2; ++ai)
#pragma unroll
                for (int m = 0; m < 4; ++m) { const int row = u.pm * BM + ai * HALF + wr * 64 + m * 16 + fr;
#pragma unroll
                    for (int bj = 0; bj < 2; ++bj) { const size_t off = (size_t)row * 1024 + u.pn * BM + bj * HALF + wc * 32 + fq * 8;
                        acc[ai][bj][m][0] = *(const f32x4*)(resid + off); acc[ai][bj][m][1] = *(const f32x4*)(resid + off + 4); } }
        } else {
            u32x4 w[2][4][2];
#pragma unroll
            for (int ai = 0; ai < 2; ++ai)
#pragma unroll
                for (int m = 0; m < 4; ++m) { const int row = u.pm * BM + ai * HALF + wr * 64 + m * 16 + fr;
#pragma unroll
                    for (int bj = 0; bj < 2; ++bj) w[ai][m][bj] = *(const u32x4*)(xb + (size_t)row * 1024 + u.pn * BM + bj * HALF + wc * 32 + fq * 8); }
            __builtin_amdgcn_sched_barrier(0);
#pragma unroll
            for (int ai = 0; ai < 2; ++ai)
#pragma unroll
                for (int m = 0; m < 4; ++m)
#pragma unroll
                    for (int bj = 0; bj < 2; ++bj) { const u32x4 x = w[ai][m][bj];
                        acc[ai][bj][m][0] = (f32x4){__uint_as_float(x.x << 16), __uint_as_float(x.x & 0xffff0000u), __uint_as_float(x.y << 16), __uint_as_float(x.y & 0xffff0000u)};
                        acc[ai][bj][m][1] = (f32x4){__uint_as_float(x.z << 16), __uint_as_float(x.z & 0xffff0000u), __uint_as_float(x.w << 16), __uint_as_float(x.w & 0xffff0000u)}; }
        }
    }
    __device__ __forceinline__ void operator()(const f32x4 (&acc)[2][2][4][2], const Unit& u, int wr, int wc, int fr, int fq) const {
#pragma unroll
        for (int ai = 0; ai < 2; ++ai)
#pragma unroll
            for (int m = 0; m < 4; ++m) {
                const int row = u.pm * BM + ai * HALF + wr * 64 + m * 16 + fr; float ss = 0.f;
#pragma unroll
                for (int bj = 0; bj < 2; ++bj) { const size_t off = (size_t)row * 1024 + u.pn * BM + bj * HALF + wc * 32 + fq * 8;
                    const f32x4 v0 = acc[ai][bj][m][0], v1 = acc[ai][bj][m][1];
                    if (xout) { __builtin_nontemporal_store(v0, (f32x4*)(xout + off)); __builtin_nontemporal_store(v1, (f32x4*)(xout + off + 4)); }
                    if (feed) *(u32x4*)(xb + off) = pack8(v0, v1);
                    const f32x4 q0 = v0 * v0, q1 = v1 * v1; ss += ((q0[0] + q0[1]) + (q0[2] + q0[3])) + ((q1[0] + q1[1]) + (q1[2] + q1[3])); }
                ss = xsum4(ss);
                if (feed && fq == 0) ssq[(size_t)row * 16 + u.pn * 4 + wc] = ss;
            }
    }
};
struct EpiUp {
    static constexpr bool PERM = true, AFTER_DRAIN = false;
    const float* ssq; bf16_t* Hid;
    __device__ __forceinline__ void init(f32x4 (&acc)[2][2][4][2], const Unit&, int, int, int, int) const { zero_acc(acc); }
    __device__ __forceinline__ void operator()(const f32x4 (&acc)[2][2][4][2], const Unit& u, int wr, int wc, int fr, int fq) const {
        float rsv[2][4];
        { f32x4 pv[2][4];
#pragma unroll
          for (int ai = 0; ai < 2; ++ai)
#pragma unroll
              for (int m = 0; m < 4; ++m) pv[ai][m] = *(const f32x4*)(ssq + (size_t)(u.pm * BM + ai * HALF + wr * 64 + m * 16 + fr) * 16 + fq * 4);
          __builtin_amdgcn_sched_barrier(0);
#pragma unroll
          for (int ai = 0; ai < 2; ++ai)
#pragma unroll
              for (int m = 0; m < 4; ++m) { const f32x4 p = pv[ai][m]; rsv[ai][m] = rsqrtf(xsum4((p[0] + p[1]) + (p[2] + p[3])) * (1.0f / 1024.0f) + EPS_); } }
#pragma unroll
        for (int ai = 0; ai < 2; ++ai)
#pragma unroll
            for (int m = 0; m < 4; ++m) {
                const int row = u.pm * BM + ai * HALF + wr * 64 + m * 16 + fr; const float rs = rsv[ai][m];
#pragma unroll
                for (int bj = 0; bj < 2; ++bj) { f32x4 v0 = acc[ai][bj][m][0] * rs, v1 = acc[ai][bj][m][1] * rs;
#pragma unroll
                    for (int i = 0; i < 4; ++i) { const float a = fmaxf(v0[i], 0.f), b = fmaxf(v1[i], 0.f); v0[i] = a * a; v1[i] = b * b; }
                    *(u32x4*)(Hid + (size_t)row * 4096 + u.pn * BM + bj * HALF + wc * 32 + fq * 8) = pack8(v0, v1); }

            }
    }
};
template <class Epi, class Sched, bool ALIGN_EPI = false, bool SP2 = false, bool ZZ = false>
__device__ __forceinline__ void gemm_phase(PG8_LAS unsigned char* lds, const Gemm g, const Sched& S, const Epi& E) {
    int tid_ = threadIdx.x; asm volatile("" : "+v"(tid_));
    const int tid = tid_, wid = __builtin_amdgcn_readfirstlane(tid >> 6), lane = tid & 63, wr = wid >> 2, wc = wid & 3, fr = lane & 15, fq = lane >> 4;
    const int K = g.K, nt = K / BK;
    unsigned voffA[2], voffB[2];
#pragma unroll
    for (int i = 0; i < 2; ++i) { int R, C; stage_rc(tid * 16 + i * 8192, R, C); const int Rb = Epi::PERM ? ((R & ~31) + perm32(R & 31)) : R;
        voffA[i] = (unsigned)(R * K + C) * 2u; voffB[i] = (unsigned)(Rb * K + C) * 2u; }
    const long kstep = (long)(BK * 2);
    const size_t hstep = (size_t)HALF * K * 2;
    const size_t tstep = 2 * hstep;
    const unsigned ldsw = (unsigned)wid * 1024u;
    const int aoff = lds_byte(wr * 64 + fr, fq * 8), boff = lds_byte(wc * 32 + fr, fq * 8);
#define PG8_SA(b, h) (((b) * 2 + (h)) * HTB)
#define PG8_SB(b, h) ((4 + (b) * 2 + (h)) * HTB)
#define PG8_STAGE(bufoff, gbase, voff) do { _Pragma("unroll") for (int _i = 0; _i < 2; ++_i) \
        __builtin_amdgcn_global_load_lds((const unsigned*)((const char*)(gbase) + (voff)[_i]), (PG8_LAS unsigned*)(lds + (bufoff) + ldsw + _i * 8192), 16, 0, 0); } while (0)
#define PG8_LDA(dst, b, h) do { _Pragma("unroll") for (int m = 0; m < 4; ++m) _Pragma("unroll") for (int k = 0; k < 2; ++k) dst[m][k] = *(const PG8_LAS bf16x8*)(lds + PG8_SA(b, h) + aoff + m * 2048 + k * 1024); } while (0)
#define PG8_LDB(dst, b, h) do { _Pragma("unroll") for (int n = 0; n < 2; ++n) _Pragma("unroll") for (int k = 0; k < 2; ++k) dst[n][k] = *(const PG8_LAS bf16x8*)(lds + PG8_SB(b, h) + boff + n * 2048 + k * 1024); } while (0)
#define PG8_MMA(ai, bj, At, Bt) do { __builtin_amdgcn_s_setprio(1); _Pragma("unroll") for (int m = 0; m < 4; ++m) _Pragma("unroll") for (int n = 0; n < 2; ++n) _Pragma("unroll") for (int k = 0; k < 2; ++k) \
        acc[ai][bj][m][n] = __builtin_amdgcn_mfma_f32_16x16x32_bf16(Bt[n][k], At[m][k], acc[ai][bj][m][n], 0, 0, 0); __builtin_amdgcn_s_setprio(0); } while (0)
#define PG8_WAIT_V(n) asm volatile("s_waitcnt vmcnt(" #n ")" ::: "memory")
#define PG8_WAIT_L(n) asm volatile("s_waitcnt lgkmcnt(" #n ")" ::: "memory")
#define PG8_BAR __builtin_amdgcn_s_barrier()
#define PG8_SCHED __builtin_amdgcn_sched_barrier(0)
    Unit cur, nxt; int ui = 0;
    if (!S.next(0, cur)) return;
    f32x4 acc[2][2][4][2];
    E.init(acc, cur, wr, wc, fr, fq);
    bf16x8 At[4][2], B0[2][2], B1[2][2];
    const char* cA = (const char*)g.A + (size_t)cur.pm * tstep; const char* cB = (const char*)g.Bt + (size_t)cur.pn * tstep;
    long ks = kstep, ksn = kstep;
    S.a_ready(cur);
    if constexpr (SP2) {
        PG8_STAGE(PG8_SB(0, 0), cB, voffB); PG8_STAGE(PG8_SB(0, 1), cB + hstep, voffB); PG8_STAGE(PG8_SA(0, 0), cA, voffA); PG8_STAGE(PG8_SA(0, 1), cA + hstep, voffA);
        if (wr == 1) PG8_BAR;
        PG8_WAIT_V(2); PG8_BAR;
        PG8_STAGE(PG8_SB(1, 0), cB + kstep, voffB); PG8_STAGE(PG8_SA(1, 0), cA + kstep, voffA); PG8_STAGE(PG8_SB(1, 1), cB + hstep + kstep, voffB);
        PG8_WAIT_V(6); PG8_BAR;
    } else {
        PG8_STAGE(PG8_SB(0, 0), cB, voffB); PG8_STAGE(PG8_SA(0, 0), cA, voffA); PG8_STAGE(PG8_SB(0, 1), cB + hstep, voffB); PG8_STAGE(PG8_SA(0, 1), cA + hstep, voffA);
        if (wr == 1) PG8_BAR;
        PG8_WAIT_V(4); PG8_BAR;
        PG8_STAGE(PG8_SB(1, 0), cB + kstep, voffB); PG8_STAGE(PG8_SA(1, 0), cA + kstep, voffA); PG8_STAGE(PG8_SB(1, 1), cB + hstep + kstep, voffB);
        PG8_WAIT_V(6); PG8_BAR;
    }
    for (;;) {
        const bool has_next = S.next(ui + 1, nxt);
        const bool nrev = ZZ && has_next && (((ui + 1) & 1) != 0); const long noff = nrev ? (long)(nt - 1) * kstep : 0l;
        ksn = has_next ? (nrev ? -kstep : kstep) : ks;
        const char* nA = has_next ? (const char*)g.A + (size_t)nxt.pm * tstep + noff : cA; const char* nB = has_next ? (const char*)g.Bt + (size_t)nxt.pn * tstep + noff : cB;
        for (int t = 0; t < nt; t += 2) {
            const bool last = (t == nt - 2);
            const char* a1 = cA + (long)(t + 1) * ks;
            const char* a2 = last ? nA : cA + (long)(t + 2) * ks; const char* b2 = last ? nB : cB + (long)(t + 2) * ks;
            const long k3 = last ? ksn : ks; const char* a3 = a2 + k3; const char* b3 = b2 + k3;
            if (last && has_next) S.a_ready(nxt);
            if constexpr (SP2) {
            PG8_LDB(B0, 0, 0); PG8_LDB(B1, 0, 1); PG8_SCHED; PG8_LDA(At, 0, 0); PG8_STAGE(PG8_SA(1, 1), a1 + hstep, voffA);
            PG8_WAIT_V(8); PG8_WAIT_L(0); PG8_BAR; PG8_MMA(0, 0, At, B0); PG8_MMA(0, 1, At, B1); PG8_BAR; PG8_SCHED;
            PG8_LDA(At, 0, 1); PG8_STAGE(PG8_SB(0, 0), b2, voffB); PG8_STAGE(PG8_SB(0, 1), b2 + hstep, voffB); PG8_STAGE(PG8_SA(0, 0), a2, voffA);
            PG8_WAIT_V(8); PG8_WAIT_L(0); PG8_BAR; PG8_MMA(1, 0, At, B0); PG8_MMA(1, 1, At, B1); PG8_BAR; PG8_SCHED;
            PG8_LDB(B0, 1, 0); PG8_LDB(B1, 1, 1); PG8_SCHED; PG8_LDA(At, 1, 0); PG8_STAGE(PG8_SA(0, 1), a2 + hstep, voffA);
            PG8_WAIT_V(8); PG8_WAIT_L(0); PG8_BAR; PG8_MMA(0, 0, At, B0); PG8_MMA(0, 1, At, B1); PG8_BAR; PG8_SCHED;
            PG8_LDA(At, 1, 1); PG8_STAGE(PG8_SB(1, 0), b3, voffB); PG8_STAGE(PG8_SB(1, 1), b3 + hstep, voffB); PG8_STAGE(PG8_SA(1, 0), a3, voffA);
            PG8_WAIT_V(8); PG8_WAIT_L(0); PG8_BAR; PG8_MMA(1, 0, At, B0); PG8_MMA(1, 1, At, B1); PG8_BAR; PG8_SCHED;
            } else {
            PG8_LDB(B0, 0, 0); PG8_SCHED; PG8_LDA(At, 0, 0); PG8_STAGE(PG8_SA(1, 1), a1 + hstep, voffA);
            PG8_WAIT_L(8); PG8_BAR; PG8_WAIT_L(0); PG8_MMA(0, 0, At, B0); PG8_BAR; PG8_SCHED;
            PG8_LDB(B1, 0, 1); PG8_STAGE(PG8_SB(0, 0), b2, voffB);
            PG8_BAR; PG8_WAIT_L(0); PG8_MMA(0, 1, At, B1); PG8_BAR;
            PG8_LDA(At, 0, 1); PG8_STAGE(PG8_SA(0, 0), a2, voffA);
            PG8_BAR; PG8_WAIT_L(0); PG8_MMA(1, 0, At, B0); PG8_BAR; PG8_SCHED;
            PG8_STAGE(PG8_SB(0, 1), b2 + hstep, voffB);
            PG8_WAIT_V(6); PG8_BAR; PG8_MMA(1, 1, At, B1); PG8_BAR;
            PG8_LDB(B0, 1, 0); PG8_SCHED; PG8_LDA(At, 1, 0); PG8_STAGE(PG8_SA(0, 1), a2 + hstep, voffA);
            PG8_WAIT_L(8); PG8_BAR; PG8_WAIT_L(0); PG8_MMA(0, 0, At, B0); PG8_BAR; PG8_SCHED;
            PG8_LDB(B1, 1, 1); PG8_STAGE(PG8_SB(1, 0), b3, voffB);
            PG8_BAR; PG8_WAIT_L(0); PG8_MMA(0, 1, At, B1); PG8_BAR;
            PG8_LDA(At, 1, 1); PG8_STAGE(PG8_SA(1, 0), a3, voffA);
            PG8_BAR; PG8_WAIT_L(0); PG8_MMA(1, 0, At, B0); PG8_BAR; PG8_SCHED;
            PG8_STAGE(PG8_SB(1, 1), b3 + hstep, voffB);
            PG8_WAIT_V(6); PG8_BAR; PG8_MMA(1, 1, At, B1); PG8_BAR;
            }
        }
        if constexpr (ALIGN_EPI) { if (wr == 0) PG8_BAR; }
        if constexpr (!Epi::AFTER_DRAIN) { E(acc, cur, wr, wc, fr, fq); S.done(cur); }
        if (!has_next) break;
        E.init(acc, nxt, wr, wc, fr, fq);
        cur = nxt; cA = nA; cB = nB; ks = ksn; ++ui;
        if constexpr (ALIGN_EPI) { if (wr == 1) PG8_BAR; }
    }
    PG8_WAIT_V(0);
    if constexpr (!ALIGN_EPI) { if (wr == 0) PG8_BAR; }
    PG8_BAR;
    if constexpr (Epi::AFTER_DRAIN) { E.fused(acc, cur, wr, wc, fr, fq, lds, wid, lane); S.done(cur); }
#undef PG8_SA
#undef PG8_SB
#undef PG8_STAGE
#undef PG8_LDA
#undef PG8_LDB
#undef PG8_MMA
#undef PG8_WAIT_V
#undef PG8_WAIT_L
#undef PG8_BAR
#undef PG8_SCHED
}
}
#define LAS __attribute__((address_space(3)))
typedef unsigned short bf16;
typedef unsigned u32x4 __attribute__((ext_vector_type(4)));
typedef unsigned u32x2 __attribute__((ext_vector_type(2)));
typedef float f32x4 __attribute__((ext_vector_type(4)));
typedef float f32x2 __attribute__((ext_vector_type(2)));
typedef short bf16x8 __attribute__((ext_vector_type(8)));
typedef float f32x16 __attribute__((ext_vector_type(16)));

#define XB_TMO      128
#define XB_XCNT(j)  (256  + 64 * (j))
#define XB_XSUB(j)  (1280 + 64 * (j))
#define XB_XGEN(j)  (2304 + 64 * (j))
#define XB_TOP      3328
#define XB_TOPGEN   3392
#define XCD_BAR_WORDS 3456
#define XB_SPIN_CAP (1u << 18)

__device__ __forceinline__ unsigned xb_ld(unsigned* p)              { return __hip_atomic_load(p, __ATOMIC_RELAXED, __HIP_MEMORY_SCOPE_AGENT); }
__device__ __forceinline__ unsigned xb_add(unsigned* p, unsigned v) { return __hip_atomic_fetch_add(p, v, __ATOMIC_RELAXED, __HIP_MEMORY_SCOPE_AGENT); }
__device__ __forceinline__ unsigned xb_xcc_id() { return (unsigned)__builtin_amdgcn_s_getreg((3 << 11) | 20) & 0xFu; }
#define XB_SPIN(cond, bar) do { unsigned _sp = 0; while (cond) { __builtin_amdgcn_s_sleep(1); \
    if ((++_sp & 255u) == 0u) { if (xb_ld(&(bar)[XB_TMO])) break; if (_sp > XB_SPIN_CAP) { atomicAdd(&(bar)[XB_TMO], 1u); break; } } } } while (0)

struct XcdBarrier {
    unsigned* bar; unsigned x;
    volatile LAS unsigned* st;
};

__device__ __forceinline__ XcdBarrier xcd_barrier_post(unsigned* bar, volatile LAS unsigned* st) {
    XcdBarrier b; b.bar = bar; b.x = xb_xcc_id(); b.st = st;
    if (threadIdx.x == 0) (void)xb_add(&bar[XB_XCNT(b.x)], 1u);
    return b;
}
__device__ __forceinline__ void xcd_barrier_complete(unsigned* bar, unsigned x, unsigned& nloc, unsigned& nx) {
    const unsigned G = gridDim.x * gridDim.y * gridDim.z;
    unsigned sum, cnt, mine, sp = 0u;
    for (;;) {
        sum = 0u; cnt = 0u; mine = 0u;
#pragma unroll
        for (unsigned j = 0; j < 16; ++j) { const unsigned c = xb_ld(&bar[XB_XCNT(j)]); sum += c; cnt += (c > 0u) ? 1u : 0u; mine = (j == x) ? c : mine; }
        if (sum == G) break;
        __builtin_amdgcn_s_sleep(1);
        if ((++sp & 255u) == 0u) { if (xb_ld(&bar[XB_TMO])) break; if (sp > XB_SPIN_CAP) { atomicAdd(&bar[XB_TMO], 1u); break; } }
    }
    nloc = mine > 0u ? mine : 1u; nx = cnt > 0u ? cnt : 1u;
}

__device__ __forceinline__ void xcd_barrier(const XcdBarrier& b) {
    asm volatile("s_waitcnt vmcnt(0)" ::: "memory");
    __syncthreads();
    if (threadIdx.x == 0) {
        unsigned* bar = b.bar;
        __builtin_amdgcn_s_waitcnt(0);
        unsigned nloc = b.st[0], nx = b.st[1];
        if (nloc == 0u) { xcd_barrier_complete(bar, b.x, nloc, nx); b.st[0] = nloc; b.st[1] = nx; }
        const unsigned old = xb_add(&bar[XB_XSUB(b.x)], 1u);
        const unsigned gen = old / nloc;
        if (old + 1u == (gen + 1u) * nloc) {
            __builtin_amdgcn_fence(__ATOMIC_RELEASE, "agent");
            asm volatile("s_waitcnt vmcnt(0)" ::: "memory");
            const unsigned og = xb_add(&bar[XB_TOP], 1u);
            const unsigned tg = og / nx;
            if (og + 1u == (tg + 1u) * nx) xb_add(&bar[XB_TOPGEN], 1u);
            else XB_SPIN(xb_ld(&bar[XB_TOPGEN]) == tg, bar);
            __builtin_amdgcn_fence(__ATOMIC_ACQUIRE, "agent");
            xb_add(&bar[XB_XGEN(b.x)], 1u);
            asm volatile("s_waitcnt vmcnt(0)" ::: "memory");
        } else {
            XB_SPIN(xb_ld(&bar[XB_XGEN(b.x)]) == gen, bar);
            __builtin_amdgcn_fence(__ATOMIC_ACQUIRE, "agent");
            asm volatile("s_waitcnt vmcnt(0)" ::: "memory");
        }
    }
    __syncthreads();
}

constexpr int NB = 4, T = 8192, D = 1024, M = NB * T, DEPTH = 4, INW = 1792, FF = 4096;
constexpr float EPS = 1e-6f, LOG2E = 1.4426950408889634f;
constexpr size_t MiB = 1u << 20;
constexpr size_t WS_WIN = 1 * MiB, WS_WOUT = 16 * MiB, WS_WUP = 24 * MiB, WS_WDN = 56 * MiB, WS_XB = 88 * MiB, WS_SSQ = 152 * MiB;
constexpr size_t WS_Q = 154 * MiB, WS_K = 186 * MiB, WS_V = 194 * MiB, WS_HG = 202 * MiB, WS_MIX = 234 * MiB;
constexpr size_t WS_HID = 154 * MiB, WS_END = 410 * MiB;
constexpr size_t SZ_WIN = (size_t)INW * D * 2, SZ_WOUT = (size_t)D * D * 2, SZ_WUP = (size_t)FF * D * 2, SZ_WDN = (size_t)D * FF * 2;
static_assert(WS_WIN + DEPTH * SZ_WIN <= WS_WOUT && WS_WOUT + DEPTH * SZ_WOUT <= WS_WUP && WS_WUP + DEPTH * SZ_WUP <= WS_WDN && WS_WDN + DEPTH * SZ_WDN <= WS_XB, "weights map");
static_assert(WS_XB + (size_t)M * D * 2 <= WS_SSQ && WS_SSQ + (size_t)M * 16 * 4 <= WS_Q && WS_MIX + (size_t)M * D * 2 <= WS_END && WS_HID + (size_t)M * FF * 2 <= WS_END, "activation map");
constexpr int KP = 144, VP = 528;
constexpr int L_K = 0, L_V = 2 * 256 * KP, L_BIAS = L_V + 2 * 64 * VP, L_SSQ = L_BIAS + 8 * 192 * 4, L_END = L_SSQ + 2 * 8 * 32 * 4;
constexpr int LDS_BYTES = 155648;
constexpr int MISC_OFF = LDS_BYTES - 256;
constexpr size_t WS_CTL = 0, CTL_ZERO_BYTES = 16384;
static_assert(L_END <= MISC_OFF && pg8::STAGE_BYTES <= MISC_OFF && XCD_BAR_WORDS * 4 <= (int)CTL_ZERO_BYTES, "LDS map");

__device__ __forceinline__ int tid_opaque() { int t = threadIdx.x; asm volatile("" : "+v"(t)); return t; }
template <int CTRL> __device__ __forceinline__ float dppf(float v) { return __builtin_bit_cast(float, __builtin_amdgcn_update_dpp(0, __builtin_bit_cast(int, v), CTRL, 0xf, 0xf, false)); }
__device__ __forceinline__ float wave_sum(float v) {
    v += dppf<0xB1>(v);
    v += dppf<0x4E>(v);
    v += dppf<0x141>(v);
    v += dppf<0x140>(v);
    const int vi = __builtin_bit_cast(int, v);
    const float r0 = __builtin_bit_cast(float, __builtin_amdgcn_readlane(vi, 0)), r1 = __builtin_bit_cast(float, __builtin_amdgcn_readlane(vi, 16));
    const float r2 = __builtin_bit_cast(float, __builtin_amdgcn_readlane(vi, 32)), r3 = __builtin_bit_cast(float, __builtin_amdgcn_readlane(vi, 48));
    return (r0 + r1) + (r2 + r3);
}
__device__ __forceinline__ unsigned pk2(float lo, float hi) { return pg8::cvt_pk_bf16(lo, hi); }

__device__ __forceinline__ int in_col_map(int n0) {
    if (n0 < 768) { const int pn = n0 >> 8, l = n0 & 255; return (pn << 8) + ((l >> 5) & 1) * 128 + (l >> 6) * 32; }
    if (n0 < 1280) { const int ch = n0 - 768; return ((3 + (ch >> 7)) << 8) + (ch & 127); }
    const int ch = n0 - 1280; return ((3 + (ch >> 7)) << 8) + 128 + (ch & 127);
}
__device__ __forceinline__ void transpose_item(const float* W, int K, int N, bf16* WT, const float* g0, const float* g1, bool inmap, LAS float* scr, int item, int lane, bool stream) {
    const int nblk = N / 32, kb = item / nblk, nb = item % nblk, k0 = 64 * kb, n0 = 32 * nb;
    float wv[32];
#pragma unroll
    for (int i = 0; i < 32; ++i) wv[i] = __builtin_nontemporal_load(W + (size_t)(k0 + 2 * i + (lane >> 5)) * N + n0 + (lane & 31));
#pragma unroll
    for (int i = 0; i < 32; ++i) { const int kk = 2 * i + (lane >> 5), k = k0 + kk; const float g = g0 ? (k < 512 ? g0[k] : g1[k - 512]) : 1.0f;
        scr[kk * 33 + (lane & 31)] = wv[i] * g; }
    asm volatile("s_waitcnt lgkmcnt(0)" ::: "memory");
    const int c = lane & 7, d0 = inmap ? in_col_map(n0) : n0;
    float tv[4][8];
#pragma unroll
    for (int j = 0; j < 4; ++j)
#pragma unroll
        for (int i = 0; i < 8; ++i) tv[j][i] = scr[(8 * c + i) * 33 + (lane >> 3) + 8 * j];
    __builtin_amdgcn_sched_barrier(0);
#pragma unroll
    for (int j = 0; j < 4; ++j) { const int n = (lane >> 3) + 8 * j;
        u32x4 o; o.x = pk2(tv[j][0], tv[j][1]); o.y = pk2(tv[j][2], tv[j][3]); o.z = pk2(tv[j][4], tv[j][5]); o.w = pk2(tv[j][6], tv[j][7]);
        if (stream) __builtin_nontemporal_store(o, (u32x4*)(WT + (size_t)(d0 + n) * K + k0 + 8 * c)); else *(u32x4*)(WT + (size_t)(d0 + n) * K + k0 + 8 * c) = o; }
    asm volatile("s_waitcnt lgkmcnt(0)" ::: "memory");
}

struct Args {
    const float* x; const float* rel_bias; const float* norm_mix_g; const float* w_in; const float* q_norm_g; const float* k_norm_g; const float* sinks;
    const float* conv_w; const float* conv_b; const float* conv_ln_g; const float* conv_ln_b; const float* attn_out_g; const float* conv_out_g; const float* w_out;
    const float* norm_mlp_g; const float* w_mlp_up; const float* w_mlp_down;
    float* out; unsigned char* ws; int ph_lo, ph_hi;
};

__device__ __forceinline__ void convert_layer(const Args& a, LAS unsigned char* lds, int l, int gw, int NGW) {
    const int tid = tid_opaque(), lane = tid & 63, wave = tid >> 6;
    LAS float* scr = (LAS float*)(lds + wave * 16384);
    constexpr int I_IN = (D / 64) * (INW / 32), I_OUT = (D / 64) * (D / 32), I_UP = (D / 64) * (FF / 32), I_DN = (FF / 64) * (D / 32), I_L = I_IN + I_OUT + I_UP + I_DN;
    for (int it = gw; it < I_L; it += NGW) {
        int r = it;
        if (r < I_IN) { transpose_item(a.w_in + (size_t)l * D * INW, D, INW, (bf16*)(a.ws + WS_WIN + l * SZ_WIN), a.norm_mix_g + l * D, a.norm_mix_g + l * D + 512, true, scr, r, lane, l > 0); continue; } r -= I_IN;
        if (r < I_OUT) { transpose_item(a.w_out + (size_t)l * D * D, D, D, (bf16*)(a.ws + WS_WOUT + l * SZ_WOUT), a.attn_out_g + l * 512, a.conv_out_g + l * 512, false, scr, r, lane, l > 0); continue; } r -= I_OUT;
        if (r < I_UP) { transpose_item(a.w_mlp_up + (size_t)l * D * FF, D, FF, (bf16*)(a.ws + WS_WUP + l * SZ_WUP), a.norm_mlp_g + l * D, a.norm_mlp_g + l * D + 512, false, scr, r, lane, l > 0); continue; } r -= I_UP;
        transpose_item(a.w_mlp_down + (size_t)l * FF * D, FF, D, (bf16*)(a.ws + WS_WDN + l * SZ_WDN), nullptr, nullptr, false, scr, r, lane, l > 0);
    }
}
__device__ __forceinline__ void prologue(const Args& a, LAS unsigned char* lds, int vcu, int G) {
    const int tid = tid_opaque(), lane = tid & 63, wave = tid >> 6;
    const int gw = vcu * 8 + wave, NGW = G * 8;
    convert_layer(a, lds, 0, gw, NGW);
    bf16* xb = (bf16*)(a.ws + WS_XB); float* ssq = (float*)(a.ws + WS_SSQ);
    const int rpb = M / G, rbase = vcu * rpb;
    for (int m0 = rbase + wave * 4; m0 < rbase + rpb; m0 += 32) {
        f32x4 v[4][4]; float s[4];
#pragma unroll
        for (int q = 0; q < 4; ++q) { const f32x4* xr = (const f32x4*)(a.x + (size_t)(m0 + q) * D) + lane;
#pragma unroll
            for (int j = 0; j < 4; ++j) v[q][j] = __builtin_nontemporal_load(xr + 64 * j); }
#pragma unroll
        for (int q = 0; q < 4; ++q) { float t = 0.f;
#pragma unroll
            for (int j = 0; j < 4; ++j) t += (v[q][j][0] * v[q][j][0] + v[q][j][1] * v[q][j][1]) + (v[q][j][2] * v[q][j][2] + v[q][j][3] * v[q][j][3]);
            s[q] = wave_sum(t); }
#pragma unroll
        for (int q = 0; q < 4; ++q) { u32x2* o8 = (u32x2*)(xb + (size_t)(m0 + q) * D) + lane;
#pragma unroll
            for (int j = 0; j < 4; ++j) { u32x2 w; w.x = pk2(v[q][j][0], v[q][j][1]); w.y = pk2(v[q][j][2], v[q][j][3]); o8[64 * j] = w; } }
        { const int q = lane >> 4, c = lane & 15; const float sq = q == 0 ? s[0] : q == 1 ? s[1] : q == 2 ? s[2] : s[3]; ssq[(size_t)(m0 + q) * 16 + c] = c == 0 ? sq : 0.f; }
    }
}

__device__ __forceinline__ void attn_bias_table(LAS unsigned char* lds, const float* rel_bias) {
    LAS float* bt = (LAS float*)(lds + L_BIAS);
    for (int i = tid_opaque(); i < 8 * 192; i += 512) { const int h = i / 192, dist = 159 - i % 192; float v = 0.f;
        if (dist >= 0 && dist < 128) { int bk = dist; if (dist >= 16) { bk = 16 + (int)(__log2f((float)dist * 0.0625f) * (16.0f / 3.0f)); bk = bk < 31 ? bk : 31; } v = rel_bias[bk * 8 + h] * LOG2E; }
        bt[i] = v; }
}
__device__ __forceinline__ void attn_stage(LAS unsigned char* lds, int b, int qb, const bf16* Kb, const bf16* Vg) {
    const int tid = tid_opaque(), tok0 = qb * 128 - 128;
#pragma unroll
    for (int it = 0; it < 8; ++it) { const int c = it * 512 + tid, kb = c >> 4, sub = c & 15, tok = tok0 + kb;
        u32x4 v = (u32x4){0u, 0u, 0u, 0u}; if (tok >= 0) v = *(const u32x4*)(Kb + ((size_t)b * T + tok) * 128 + sub * 8);
        *(LAS u32x4*)(lds + L_K + (sub >> 3) * 256 * KP + kb * KP + (sub & 7) * 16) = v; }
#pragma unroll
    for (int it = 0; it < 8; ++it) { const int c = it * 512 + tid, kb = c & 255, grp = c >> 8, tok = tok0 + kb;
        u32x4 v = (u32x4){0u, 0u, 0u, 0u}; if (tok >= 0) v = *(const u32x4*)(Vg + ((size_t)(b * 16 + grp) * T + tok) * 8);
        const int pos = (kb & ~12) | ((kb & 4) << 1) | ((kb & 8) >> 1);
        LAS unsigned short* d = (LAS unsigned short*)(lds + L_V + (grp >> 3) * 64 * VP + (grp & 7) * 8 * VP + pos * 2);
        d[0 * (VP / 2)] = (unsigned short)(v.x & 0xffffu); d[1 * (VP / 2)] = (unsigned short)(v.x >> 16);
        d[2 * (VP / 2)] = (unsigned short)(v.y & 0xffffu); d[3 * (VP / 2)] = (unsigned short)(v.y >> 16);
        d[4 * (VP / 2)] = (unsigned short)(v.z & 0xffffu); d[5 * (VP / 2)] = (unsigned short)(v.z >> 16);
        d[6 * (VP / 2)] = (unsigned short)(v.w & 0xffffu); d[7 * (VP / 2)] = (unsigned short)(v.w >> 16); }
}
__device__ __forceinline__ void attn_compute(LAS unsigned char* lds, int b, int qb, const bf16* Q, bf16* mix, const float* sinks_l) {
    const int tid = tid_opaque(), lane = tid & 63, r32 = lane & 31, hi = lane >> 5;
    const int h = __builtin_amdgcn_readfirstlane(tid >> 6), kvh = h >> 2;
    const LAS float* bR = (const LAS float*)(lds + L_BIAS) + h * 192 + 31 - (r32 - 4 * hi);
    const LAS unsigned char* Kl = lds + L_K + kvh * 256 * KP + r32 * KP + hi * 16;
    const LAS unsigned char* Vl = lds + L_V + kvh * 64 * VP + r32 * VP + hi * 16;
    const size_t rowbase = (size_t)b * T + (size_t)qb * 128;
    const int jmin = (qb == 0) ? 4 : 0;
    const float sink2 = sinks_l[h] * LOG2E;
    const bf16* qp = Q + (rowbase + r32) * 512 + h * 64 + hi * 8;
    bf16x8 qn[4];
#pragma unroll
    for (int ds = 0; ds < 4; ++ds) qn[ds] = *(const bf16x8*)(qp + ds * 16);
#pragma unroll 1
    for (int rb = 0; rb < 4; ++rb) {
        bf16x8 qf[4];
#pragma unroll
        for (int ds = 0; ds < 4; ++ds) qf[ds] = qn[ds];
        if (rb < 3) {
#pragma unroll
            for (int ds = 0; ds < 4; ++ds) qn[ds] = *(const bf16x8*)(qp + (size_t)(rb + 1) * 32 * 512 + ds * 16);
        }
        f32x16 s[5];
        bf16x8 kf[2][4];
#pragma unroll
        for (int ds = 0; ds < 4; ++ds) kf[0][ds] = *(const LAS bf16x8*)(Kl + (32 * rb) * KP + ds * 32);
#pragma unroll
        for (int j = 0; j < 5; ++j) {
            if (j < 4) {
#pragma unroll
                for (int ds = 0; ds < 4; ++ds) kf[(j + 1) & 1][ds] = *(const LAS bf16x8*)(Kl + (32 * (rb + j + 1)) * KP + ds * 32);
            }
            __builtin_amdgcn_sched_barrier(0);
            const float s0 = ((rb + j) >= jmin) ? 0.f : -1e30f;
#pragma unroll
            for (int r = 0; r < 16; ++r) s[j][r] = s0;
#pragma unroll
            for (int ds = 0; ds < 4; ++ds) s[j] = __builtin_amdgcn_mfma_f32_32x32x16_bf16(kf[j & 1][ds], qf[ds], s[j], 0, 0, 0);
            __builtin_amdgcn_sched_barrier(0);
        }
        float mx = sink2;
        const int tq = r32 - 4 * hi;
        f32x2 sv[5][8];
        f32x2 bz[2][8];
#pragma unroll
        for (int r2 = 0; r2 < 8; ++r2) { const int kc = ((2 * r2) & 3) + 8 * ((2 * r2) >> 2); bz[0][r2] = (f32x2){bR[kc], bR[kc + 1]}; }
#pragma unroll
        for (int j = 0; j < 5; ++j) {
            if (j < 4) {
#pragma unroll
                for (int r2 = 0; r2 < 8; ++r2) { const int kc = ((2 * r2) & 3) + 8 * ((2 * r2) >> 2); bz[(j + 1) & 1][r2] = (f32x2){bR[32 * (j + 1) + kc], bR[32 * (j + 1) + kc + 1]}; }
            }
            __builtin_amdgcn_sched_barrier(0);
#pragma unroll
            for (int r2 = 0; r2 < 8; ++r2) { const int r = 2 * r2, kc = (r & 3) + 8 * (r >> 2);
                f32x2 v = (f32x2){s[j][r], s[j][r + 1]} + bz[j & 1][r2];
                if (j == 0) v += (f32x2){(kc > tq) ? 0.f : -1e30f, (kc + 1 > tq) ? 0.f : -1e30f};
                if (j == 4) v += (f32x2){(kc <= tq) ? 0.f : -1e30f, (kc + 1 <= tq) ? 0.f : -1e30f};
                sv[j][r2] = v; mx = fmaxf(mx, fmaxf(v[0], v[1])); }
            __builtin_amdgcn_sched_barrier(0);
        }
        { const auto sw = __builtin_amdgcn_permlane32_swap(__float_as_uint(mx), __float_as_uint(mx), false, false); mx = fmaxf(__uint_as_float(sw[0]), __uint_as_float(sw[1])); }
        f32x2 l2 = (f32x2){0.f, 0.f}; const f32x2 mx2 = (f32x2){mx, mx};
        f32x16 o[2];
#pragma unroll
        for (int r = 0; r < 16; ++r) { o[0][r] = 0.f; o[1][r] = 0.f; }
        bf16x8 vf[2][4];
#pragma unroll
        for (int q = 0; q < 4; ++q) vf[0][q] = *(const LAS bf16x8*)(Vl + (q & 1) * 32 * VP + (32 * rb + 16 * (q >> 1)) * 2);
#pragma unroll
        for (int j = 0; j < 5; ++j) {
            if (j < 4) {
#pragma unroll
                for (int q = 0; q < 4; ++q) vf[(j + 1) & 1][q] = *(const LAS bf16x8*)(Vl + (q & 1) * 32 * VP + (32 * (rb + j + 1) + 16 * (q >> 1)) * 2);
            }
            __builtin_amdgcn_sched_barrier(0);
#pragma unroll
            for (int r2 = 0; r2 < 8; ++r2) { const f32x2 d = sv[j][r2] - mx2; f32x2 p; p[0] = __builtin_amdgcn_exp2f(d[0]); p[1] = __builtin_amdgcn_exp2f(d[1]); sv[j][r2] = p; l2 += p; }
#pragma unroll
            for (int sh = 0; sh < 2; ++sh) {
                u32x4 pw; pw.x = pk2(sv[j][4 * sh + 0][0], sv[j][4 * sh + 0][1]); pw.y = pk2(sv[j][4 * sh + 1][0], sv[j][4 * sh + 1][1]); pw.z = pk2(sv[j][4 * sh + 2][0], sv[j][4 * sh + 2][1]); pw.w = pk2(sv[j][4 * sh + 3][0], sv[j][4 * sh + 3][1]);
                const bf16x8 pf = __builtin_bit_cast(bf16x8, pw);
#pragma unroll
                for (int dt = 0; dt < 2; ++dt) o[dt] = __builtin_amdgcn_mfma_f32_32x32x16_bf16(vf[j & 1][sh * 2 + dt], pf, o[dt], 0, 0, 0);
            }
            __builtin_amdgcn_sched_barrier(0);
        }
        float l = l2[0] + l2[1];
        { const auto sw = __builtin_amdgcn_permlane32_swap(__float_as_uint(l), __float_as_uint(l), false, false); l = __uint_as_float(sw[0]) + __uint_as_float(sw[1]); }
        l += __builtin_amdgcn_exp2f(sink2 - mx);
        const float inv = __builtin_amdgcn_rcpf(l);
        f32x2 ov[2][8]; f32x2 ss2 = (f32x2){0.f, 0.f}; const f32x2 inv2 = (f32x2){inv, inv};
#pragma unroll
        for (int dt = 0; dt < 2; ++dt)
#pragma unroll
            for (int r2 = 0; r2 < 8; ++r2) { ov[dt][r2] = (f32x2){o[dt][2 * r2], o[dt][2 * r2 + 1]} * inv2; ss2 += ov[dt][r2] * ov[dt][r2]; }
        float ss = ss2[0] + ss2[1];
        { const auto sw = __builtin_amdgcn_permlane32_swap(__float_as_uint(ss), __float_as_uint(ss), false, false); ss = __uint_as_float(sw[0]) + __uint_as_float(sw[1]); }
        LAS float* X = (LAS float*)(lds + L_SSQ) + (rb & 1) * 256;
        if (hi == 0) X[h * 32 + r32] = ss;
        __syncthreads();
        float tot = 0.f;
#pragma unroll
        for (int hh = 0; hh < 8; ++hh) tot += X[hh * 32 + r32];
        const float rr = rsqrtf(tot * (1.0f / 512.0f) + EPS);
        bf16* op = mix + (rowbase + rb * 32 + r32) * 1024 + h * 64 + 8 * hi;
        const f32x2 rr2 = (f32x2){rr, rr};
#pragma unroll
        for (int dt = 0; dt < 2; ++dt)
#pragma unroll
            for (int k = 0; k < 4; k += 2) {
                const f32x2 a0 = ov[dt][2 * k] * rr2, a1 = ov[dt][2 * k + 1] * rr2, b0 = ov[dt][2 * k + 2] * rr2, b1 = ov[dt][2 * k + 3] * rr2;
                unsigned ax = pk2(a0[0], a0[1]), ay = pk2(a1[0], a1[1]), bx_ = pk2(b0[0], b0[1]), by = pk2(b1[0], b1[1]);
                { const auto r = __builtin_amdgcn_permlane32_swap(ax, bx_, false, false); ax = r[0]; bx_ = r[1]; }
                { const auto r = __builtin_amdgcn_permlane32_swap(ay, by, false, false); ay = r[0]; by = r[1]; }
                u32x4 w; w.x = ax; w.y = ay; w.z = bx_; w.w = by;
                *(u32x4*)(op + dt * 32 + 8 * k) = w; }
    }
}

constexpr int CT = 16, CWIN = CT + 30, CITEM = 2 * CT;
template <int S> __device__ __forceinline__ unsigned conv_ld(const bf16* hp, int tt) {
    unsigned hv = 0u; if (S >= 30 || tt - 30 + S >= 0) hv = *(const unsigned*)(hp + (long)S * 512); return hv;
}
template <int S> __device__ __forceinline__ void conv_fma(f32x2 (&acc)[CT], const f32x2 (&w)[31], unsigned hv) {
    f32x2 hf; hf[0] = __uint_as_float(hv << 16); hf[1] = __uint_as_float(hv & 0xffff0000u);
#pragma unroll
    for (int j = 0; j < 31; ++j) { const int tok = S - j; if (tok >= 0 && tok < CT) acc[tok] += w[j] * hf; }
}
template <int... I> __device__ __forceinline__ void conv_load_all(std::integer_sequence<int, I...>, unsigned (&hv)[CWIN], const bf16* hp, int tt) { ((hv[I] = conv_ld<I>(hp, tt)), ...); }
template <int... I> __device__ __forceinline__ void conv_fma_all(std::integer_sequence<int, I...>, f32x2 (&acc)[CT], const f32x2 (&w)[31], const unsigned (&hv)[CWIN]) { (conv_fma<I>(acc, w, hv[I]), ...); }
__device__ __forceinline__ void conv_weights(f32x2 (&w)[31], f32x2& bias, const float* cw, const float* cb) {
    const int cp = tid_opaque() & 255;
#pragma unroll
    for (int j = 0; j < 31; ++j) w[j] = *(const f32x2*)(cw + j * 512 + 2 * cp);
    bias = *(const f32x2*)(cb + 2 * cp);
}
__device__ __forceinline__ void conv_phase(LAS unsigned char* lds, int bx, int G, const bf16* Hg, const float* cw, const float* cb, const float* lg, const float* lb, bf16* mix) {
    const int tid = tid_opaque(), cp = tid & 255, half = tid >> 8, lane = tid & 63, wave = tid >> 6;
    constexpr int NIT = M / CITEM;
    f32x2 w[31]; f32x2 bias; conv_weights(w, bias, cw, cb);
    const f32x4 g0 = *(const f32x4*)(lg + lane * 8), g1 = *(const f32x4*)(lg + lane * 8 + 4), b0 = *(const f32x4*)(lb + lane * 8), b1 = *(const f32x4*)(lb + lane * 8 + 4);
    unsigned hv[CWIN];
    const int per = (NIT + G - 1) / G, itend = (bx + 1) * per < NIT ? (bx + 1) * per : NIT;
    int it = bx * per, par = 0;
    if (it < itend) { const int ts = it * CITEM + half * CT; conv_load_all(std::make_integer_sequence<int, CWIN>{}, hv, Hg + ((long)ts - 30) * 512 + 2 * cp, ts & (T - 1)); }
#pragma unroll 1
    for (; it < itend; ++it, par ^= 1) {
        f32x2 acc[CT];
#pragma unroll
        for (int k = 0; k < CT; ++k) acc[k] = bias;
        conv_fma_all(std::make_integer_sequence<int, CWIN>{}, acc, w, hv);
        LAS float* Y = (LAS float*)lds + par * (CITEM * 512);
#pragma unroll
        for (int k = 0; k < CT; ++k) *(LAS f32x2*)(Y + (half * CT + k) * 512 + 2 * cp) = acc[k];
        { const int nit = it + 1; if (nit < itend) { const int ts = nit * CITEM + half * CT; conv_load_all(std::make_integer_sequence<int, CWIN>{}, hv, Hg + ((long)ts - 30) * 512 + 2 * cp, ts & (T - 1)); } }
        __syncthreads();
        constexpr int NT = CITEM / 8;
        f32x4 y0[NT], y1[NT]; float red[NT];
#pragma unroll
        for (int k = 0; k < NT; ++k) { const int tok = wave * NT + k; y0[k] = *(const LAS f32x4*)(Y + tok * 512 + lane * 8); y1[k] = *(const LAS f32x4*)(Y + tok * 512 + lane * 8 + 4); }
#pragma unroll
        for (int k = 0; k < NT; ++k) red[k] = ((y0[k][0] + y0[k][1]) + (y0[k][2] + y0[k][3])) + ((y1[k][0] + y1[k][1]) + (y1[k][2] + y1[k][3]));
#pragma unroll
        for (int k = 0; k < NT; ++k) red[k] = wave_sum(red[k]) * (1.0f / 512.0f);
#pragma unroll
        for (int k = 0; k < NT; ++k) { y0[k] = y0[k] - red[k]; y1[k] = y1[k] - red[k]; const f32x4 q0 = y0[k] * y0[k], q1 = y1[k] * y1[k]; red[k] = ((q0[0] + q0[1]) + (q0[2] + q0[3])) + ((q1[0] + q1[1]) + (q1[2] + q1[3])); }
#pragma unroll
        for (int k = 0; k < NT; ++k) red[k] = rsqrtf(wave_sum(red[k]) * (1.0f / 512.0f) + EPS);
#pragma unroll
        for (int k = 0; k < NT; ++k) { y0[k] = y0[k] * red[k] * g0 + b0; y1[k] = y1[k] * red[k] * g1 + b1; float ss = 0.f;
#pragma unroll
            for (int i = 0; i < 4; ++i) { y0[k][i] = y0[k][i] * __builtin_amdgcn_rcpf(1.0f + __expf(-y0[k][i])); y1[k][i] = y1[k][i] * __builtin_amdgcn_rcpf(1.0f + __expf(-y1[k][i])); ss += y0[k][i] * y0[k][i] + y1[k][i] * y1[k][i]; }
            red[k] = ss; }
#pragma unroll
        for (int k = 0; k < NT; ++k) red[k] = rsqrtf(wave_sum(red[k]) * (1.0f / 512.0f) + EPS);
#pragma unroll
        for (int k = 0; k < NT; ++k) { const int tok = wave * NT + k; const float rr = red[k];
            u32x4 o; o.x = pk2(y0[k][0] * rr, y0[k][1] * rr); o.y = pk2(y0[k][2] * rr, y0[k][3] * rr); o.z = pk2(y1[k][0] * rr, y1[k][1] * rr); o.w = pk2(y1[k][2] * rr, y1[k][3] * rr);
            *(u32x4*)(mix + ((size_t)it * CITEM + tok) * 1024 + 512 + lane * 8) = o; }
    }
    __syncthreads();
}

#ifndef MK_N_LAUNCHES
#define MK_N_LAUNCHES 1
#endif
#ifndef MLP_SPLIT
#define MLP_SPLIT 2
#endif
constexpr int PPL = 3 + 2 * MLP_SPLIT, NPHASE = 1 + PPL * DEPTH;
__global__ void __launch_bounds__(512, 2) fwd_kernel(Args a) {
    extern __shared__ __attribute__((aligned(16))) unsigned char lds_raw[];
    LAS unsigned char* lds = (LAS unsigned char*)lds_raw;
    cg::grid_group grid = cg::this_grid();
    const int G = gridDim.x, bx = blockIdx.x, vcu = (G % 8 == 0) ? (bx % 8) * (G / 8) + bx / 8 : bx;
    const int lo = a.ph_lo, hi = a.ph_hi;
#define IN(k) (lo <= (k) && (k) < hi)
    volatile LAS unsigned* MISC = (volatile LAS unsigned*)(lds + MISC_OFF);
    if (threadIdx.x < 64) MISC[threadIdx.x] = 0u;
    __syncthreads();
    XcdBarrier bar; bar.bar = (unsigned*)(a.ws + WS_CTL); bar.x = 0; bar.st = nullptr;
    if (hi - lo > 1) bar = xcd_barrier_post((unsigned*)(a.ws + WS_CTL), MISC + 8);
    if (lo < 0) grid.sync();
#define SEAM(k) do { if ((k) + 1 < hi) xcd_barrier(bar); } while (0)
    bf16* xb = (bf16*)(a.ws + WS_XB); float* ssq = (float*)(a.ws + WS_SSQ);
    bf16* Qb = (bf16*)(a.ws + WS_Q); bf16* Kb = (bf16*)(a.ws + WS_K); bf16* Vg = (bf16*)(a.ws + WS_V); bf16* Hg = (bf16*)(a.ws + WS_HG); bf16* mix = (bf16*)(a.ws + WS_MIX); bf16* hid = (bf16*)(a.ws + WS_HID);
    if (IN(0)) { prologue(a, lds, vcu, G); __syncthreads(); SEAM(0); }
#pragma unroll 1
    for (int l = 0; l < DEPTH; ++l) {
        const int k0 = 1 + PPL * l;
        if (IN(k0)) {
            pg8::Gemm g{xb, (const bf16*)(a.ws + WS_WIN + l * SZ_WIN), M, INW, D}; pg8::StaticOrder S; S.init(M, INW, G, bx);
            pg8::EpiIn E{ssq, a.q_norm_g + l * 64, a.k_norm_g + l * 64, Qb, Kb, Vg, Hg};
            pg8::gemm_phase<pg8::EpiIn, pg8::StaticOrder, true, true, true>(lds, g, S, E);
            if (l + 1 < DEPTH) {
                constexpr int NU = (M / 256) * (INW / 256); const int rounds = (NU + G - 1) / G, nlast = NU - (rounds - 1) * G, first = (nlast >= G) ? 0 : nlast;
                if (bx >= first) convert_layer(a, lds, l + 1, (bx - first) * 8 + (tid_opaque() >> 6), (G - first) * 8);
            }
            SEAM(k0);
        }
        if (IN(k0 + 1)) {
            attn_bias_table(lds, a.rel_bias);
            for (int it = vcu; it < NB * (T / 128); it += G) { const int b = it / (T / 128), qb = it % (T / 128);
                __syncthreads(); attn_stage(lds, b, qb, Kb, Vg); __syncthreads();
                attn_compute(lds, b, qb, Qb, mix, a.sinks + l * 8); }
            __syncthreads();
            conv_phase(lds, vcu, G, Hg, a.conv_w + (size_t)l * 31 * 512, a.conv_b + l * 512, a.conv_ln_g + l * 512, a.conv_ln_b + l * 512, mix);
            SEAM(k0 + 1);
        }
        if (IN(k0 + 2)) {
            pg8::Gemm g{mix, (const bf16*)(a.ws + WS_WOUT + l * SZ_WOUT), M, D, D}; pg8::StaticOrder S; S.init(M, D, G, bx);
#if RES_BF16
            pg8::EpiRes E{nullptr, nullptr, xb, ssq, true};
#else
            pg8::EpiRes E{l == 0 ? a.x : a.out, a.out, xb, ssq, true};
#endif
            pg8::gemm_phase<pg8::EpiRes, pg8::StaticOrder, true, true, true>(lds, g, S, E);
            SEAM(k0 + 2);
        }
#pragma unroll 1
        for (int hf = 0; hf < MLP_SPLIT; ++hf) {
            constexpr int MS = M / MLP_SPLIT; const size_t r0 = (size_t)hf * MS;
            const int ku = k0 + 3 + 2 * hf, kd = ku + 1;
            if (IN(ku)) {
                pg8::Gemm g{xb + r0 * D, (const bf16*)(a.ws + WS_WUP + l * SZ_WUP), MS, FF, D}; pg8::StaticOrder S; S.init(MS, FF, G, bx);
                pg8::EpiUp E{ssq + r0 * 16, hid};
                pg8::gemm_phase<pg8::EpiUp, pg8::StaticOrder, true, true, true>(lds, g, S, E);
                SEAM(ku);
            }
            if (IN(kd)) {
                pg8::Gemm g{hid, (const bf16*)(a.ws + WS_WDN + l * SZ_WDN), MS, D, FF}; pg8::StaticOrder S; S.init(MS, D, G, bx);
#if RES_BF16
                pg8::EpiRes E{nullptr, l == DEPTH - 1 ? a.out + r0 * D : nullptr, xb + r0 * D, ssq + r0 * 16, l != DEPTH - 1};
#else
                pg8::EpiRes E{a.out + r0 * D, a.out + r0 * D, xb + r0 * D, ssq + r0 * 16, l != DEPTH - 1};
#endif
                pg8::gemm_phase<pg8::EpiRes, pg8::StaticOrder, true, true, true>(lds, g, S, E);
                SEAM(kd);
            }
        }
    }
#undef IN
#undef SEAM
}

extern "C" void kernel_launch(void* const* d_in, const int* in_sizes, int n_in, void* d_out, int out_size, void* d_ws, size_t ws_size, hipStream_t stream) {
    static int grid = 0;
    if (grid == 0) {
        if (n_in != 17 || in_sizes[0] != M * D || out_size != M * D || ws_size < WS_END) { fprintf(stderr, "kernel_launch: unexpected shapes (n_in %d, in0 %d, out %d, ws %zu); nothing launched\n", n_in, n_in > 0 ? in_sizes[0] : -1, out_size, ws_size); grid = -1; return; }
        int dev = 0, cus = 0, per_cu = 0;
        if (hipGetDevice(&dev) != hipSuccess || hipDeviceGetAttribute(&cus, hipDeviceAttributeMultiprocessorCount, dev) != hipSuccess) { grid = -1; return; }
        if (hipFuncSetAttribute((const void*)fwd_kernel, hipFuncAttributeMaxDynamicSharedMemorySize, LDS_BYTES) != hipSuccess) { fprintf(stderr, "kernel_launch: hipFuncSetAttribute failed\n"); grid = -1; return; }
        if (hipOccupancyMaxActiveBlocksPerMultiprocessor(&per_cu, (const void*)fwd_kernel, 512, LDS_BYTES) != hipSuccess || per_cu < 1) { fprintf(stderr, "kernel_launch: occupancy query says %d\n", per_cu); per_cu = 1; }
        (void)hipGetLastError();
        grid = cus * per_cu;
        if (M % grid != 0 || (M / grid) % 32 != 0) { fprintf(stderr, "kernel_launch: grid %d does not divide the rows into 32-row multiples; nothing launched\n", grid); grid = -1; return; }
    }
    if (grid < 0) return;
    Args a{};
    const float** p = (const float**)&a;
    for (int i = 0; i < 17; ++i) p[i] = (const float*)d_in[i];
    a.out = (float*)d_out; a.ws = (unsigned char*)d_ws;
#if MK_N_LAUNCHES == 1
    if (hipMemsetAsync((char*)d_ws + WS_CTL, 0, CTL_ZERO_BYTES, stream) != hipSuccess) { fprintf(stderr, "kernel_launch: memset of the barrier words failed\n"); return; }
    a.ph_lo = 0; a.ph_hi = NPHASE;
    void* args[] = {&a};
    hipError_t e = hipLaunchCooperativeKernel((const void*)fwd_kernel, dim3(grid), dim3(512), args, LDS_BYTES, stream);
    if (e != hipSuccess) fprintf(stderr, "kernel_launch: cooperative launch failed: %s (grid %d)\n", hipGetErrorString(e), grid);
#else
    for (int ph = 0; ph < NPHASE; ++ph) { a.ph_lo = ph; a.ph_hi = ph + 1; hipLaunchKernelGGL(fwd_kernel, dim3(grid), dim3(512), LDS_BYTES, stream, a); }
#endif
}
```
